# Optimizing an MI355X kernel written in HIP

```python
import math
import jax, jax.numpy as jnp
from jax import lax
import numpy as np

D_MODEL = 1024
BATCH = 2
SEQ = 8192
DEPTH = 4

CHUNK = 64
N_META = 16
N_A = DEPTH // 2
N_B = DEPTH - N_A
D_FF = 2816
POOL_WINDOWS = (2, 4, 8, 16)
N_POOL_GROUPS = len(POOL_WINDOWS)
POOL_GROUP = D_MODEL // N_POOL_GROUPS
N_HEADS = 8
QK_NOPE = 64
QK_ROPE = 32
V_HEAD = 64
KV_RANK = 256
Q_RANK = 384
ROPE_THETA = 10000.0
Q_BLOCK = 128
EPS = 1e-6

kernel_name = "yoco_pool_mla_macaron_trunk"


def rmsnorm(x, g):
    xf = x.astype(jnp.float32)
    xf = xf * lax.rsqrt(jnp.mean(xf * xf, axis=-1, keepdims=True) + EPS)
    return xf.astype(x.dtype) * g


def swiglu(h, w_gate, w_up, w_down):
    return (jax.nn.silu(h @ w_gate) * (h @ w_up)) @ w_down


def chunk_ids(n):
    pos = jnp.arange(n)
    return jnp.where(pos < N_META, 0, (pos - N_META) // CHUNK + 1)


def rope_tables(n):
    inv = 1.0 / (ROPE_THETA ** (jnp.arange(0, QK_ROPE, 2, dtype=jnp.float32) / QK_ROPE))
    ang = jnp.arange(n, dtype=jnp.float32)[:, None] * inv[None, :]
    return jnp.cos(ang), jnp.sin(ang)


def apply_rope(x, cos, sin):
    xf = x.astype(jnp.float32)
    x1, x2 = xf[..., : QK_ROPE // 2], xf[..., QK_ROPE // 2:]
    out = jnp.concatenate([x1 * cos - x2 * sin, x2 * cos + x1 * sin], axis=-1)
    return out.astype(x.dtype)


def pool_mixer(h, w_group, scale):
    L = h.shape[1]
    hf = h.astype(jnp.float32)
    cs = jnp.concatenate([jnp.zeros_like(hf[:, :1]), jnp.cumsum(hf, axis=1)], axis=1)
    hi = jnp.arange(1, L + 1)
    outs = []
    for g, w in enumerate(POOL_WINDOWS):
        sl = slice(g * POOL_GROUP, (g + 1) * POOL_GROUP)
        lo = jnp.maximum(hi - w, 0)
        c = cs[..., sl]
        count = (hi - lo).astype(jnp.float32)[None, :, None]
        mean = (jnp.take(c, hi, axis=1) - jnp.take(c, lo, axis=1)) / count
        outs.append(mean - hf[..., sl])
    pooled = jnp.stack(outs, axis=2).astype(h.dtype)
    y = jnp.einsum('blgc,gcd->blgd', pooled, w_group)
    return y.reshape(h.shape) * scale


def mla_shared_kv(h, w_dkv, kv_latent_norm, w_uk, w_uv, cos, sin):
    B, L, _ = h.shape
    ckr = h @ w_dkv
    c_kv = rmsnorm(ckr[..., :KV_RANK], kv_latent_norm)
    k_rope = apply_rope(ckr[..., KV_RANK:], cos, sin)
    k_nope = (c_kv @ w_uk).reshape(B, L, N_HEADS, QK_NOPE)
    v = (c_kv @ w_uv).reshape(B, L, N_HEADS, V_HEAD)
    return k_nope, k_rope, v


def mla_attention(h, w_dq, q_latent_norm, w_uq, w_o, k_nope, k_rope, v, cos, sin):
    B, L, _ = h.shape
    cq = rmsnorm(h @ w_dq, q_latent_norm)
    q = (cq @ w_uq).reshape(B, L, N_HEADS, QK_NOPE + QK_ROPE)
    q_nope = q[..., :QK_NOPE]
    q_rope = apply_rope(q[..., QK_NOPE:], cos[:, None, :], sin[:, None, :])
    n_blk = -(-L // Q_BLOCK)
    Lp = n_blk * Q_BLOCK
    pad = ((0, 0), (0, Lp - L), (0, 0), (0, 0))
    qn_b = jnp.pad(q_nope, pad).reshape(B, n_blk, Q_BLOCK, N_HEADS, QK_NOPE).transpose(1, 0, 2, 3, 4)
    qr_b = jnp.pad(q_rope, pad).reshape(B, n_blk, Q_BLOCK, N_HEADS, QK_ROPE).transpose(1, 0, 2, 3, 4)
    qid_b = chunk_ids(Lp).reshape(n_blk, Q_BLOCK)
    kid = chunk_ids(L)
    sm_scale = 1.0 / math.sqrt(QK_NOPE + QK_ROPE)

    def block(args):
        qn, qr, qid = args
        s = (jnp.einsum('bqhd,bkhd->bhqk', qn, k_nope)
             + jnp.einsum('bqhr,bkr->bhqk', qr, k_rope)).astype(jnp.float32) * sm_scale
        mask = kid[None, :] <= qid[:, None]
        s = jnp.where(mask[None, None], s, jnp.finfo(jnp.float32).min)
        p = jax.nn.softmax(s, axis=-1).astype(v.dtype)
        return jnp.einsum('bhqk,bkhd->bqhd', p, v)

    o = lax.map(block, (qn_b, qr_b, qid_b))
    o = o.transpose(1, 0, 2, 3, 4).reshape(B, Lp, N_HEADS * V_HEAD)[:, :L]
    return o @ w_o


def setup_inputs(seed: int = 0) -> dict:
    key = jax.random.key(seed)
    ks = iter(jax.random.split(key, 40))
    f32 = jnp.float32

    def nrm(shape, fan_in):
        return jax.random.normal(next(ks), shape, f32) * (fan_in ** -0.5)

    def gain(shape):
        return 1.0 + 0.1 * jax.random.normal(next(ks), shape, f32)

    return {
        "x": jax.random.normal(next(ks), (BATCH, SEQ, D_MODEL), f32),
        "meta_tokens": jax.random.normal(next(ks), (N_META, D_MODEL), f32),
        "ffn1_norm": gain((DEPTH, D_MODEL)),
        "ffn1_w_gate": nrm((DEPTH, D_MODEL, D_FF), D_MODEL),
        "ffn1_w_up": nrm((DEPTH, D_MODEL, D_FF), D_MODEL),
        "ffn1_w_down": nrm((DEPTH, D_FF, D_MODEL), D_FF),
        "mix_norm": gain((DEPTH, D_MODEL)),
        "ffn2_norm": gain((DEPTH, D_MODEL)),
        "ffn2_w_gate": nrm((DEPTH, D_MODEL, D_FF), D_MODEL),
        "ffn2_w_up": nrm((DEPTH, D_MODEL, D_FF), D_MODEL),
        "ffn2_w_down": nrm((DEPTH, D_FF, D_MODEL), D_FF),
        "pool_w": nrm((N_A, N_POOL_GROUPS, POOL_GROUP, POOL_GROUP), POOL_GROUP),
        "pool_scale": gain((N_A, D_MODEL)),
        "kv_in_norm": gain((D_MODEL,)),
        "w_dkv": nrm((D_MODEL, KV_RANK + QK_ROPE), D_MODEL),
        "kv_latent_norm": gain((KV_RANK,)),
        "w_uk": nrm((KV_RANK, N_HEADS * QK_NOPE), KV_RANK),
        "w_uv": nrm((KV_RANK, N_HEADS * V_HEAD), KV_RANK),
        "w_dq": nrm((N_B, D_MODEL, Q_RANK), D_MODEL),
        "q_latent_norm": gain((N_B, Q_RANK)),
        "w_uq": nrm((N_B, Q_RANK, N_HEADS * (QK_NOPE + QK_ROPE)), Q_RANK),
        "w_o": nrm((N_B, N_HEADS * V_HEAD, D_MODEL), N_HEADS * V_HEAD),
        "final_norm": gain((D_MODEL,)),
    }


def reference(x, meta_tokens, ffn1_norm, ffn1_w_gate, ffn1_w_up, ffn1_w_down, mix_norm,
              ffn2_norm, ffn2_w_gate, ffn2_w_up, ffn2_w_down, pool_w, pool_scale,
              kv_in_norm, w_dkv, kv_latent_norm, w_uk, w_uv, w_dq, q_latent_norm, w_uq, w_o,
              final_norm):
    B = x.shape[0]
    meta = jnp.broadcast_to(meta_tokens[None].astype(x.dtype), (B, N_META, D_MODEL))
    h = jnp.concatenate([meta, x], axis=1)
    L = h.shape[1]
    cos, sin = rope_tables(L)
    shared = None
    for l in range(DEPTH):
        h = h + 0.5 * swiglu(rmsnorm(h, ffn1_norm[l]), ffn1_w_gate[l], ffn1_w_up[l], ffn1_w_down[l])
        u = rmsnorm(h, mix_norm[l])
        if l < N_A:
            h = h + pool_mixer(u, pool_w[l], pool_scale[l])
        else:
            j = l - N_A
            k_nope, k_rope, v = shared
            h = h + mla_attention(u, w_dq[j], q_latent_norm[j], w_uq[j], w_o[j],
                                  k_nope, k_rope, v, cos, sin)
        h = h + 0.5 * swiglu(rmsnorm(h, ffn2_norm[l]), ffn2_w_gate[l], ffn2_w_up[l], ffn2_w_down[l])
        if l == N_A - 1:
            shared = mla_shared_kv(rmsnorm(h, kv_in_norm), w_dkv, kv_latent_norm, w_uk, w_uv, cos, sin)
    out = rmsnorm(h, final_norm)
    return out[:, N_META:]
```

```cpp
#include <hip/hip_runtime.h>
#include <hip/hip_bf16.h>
#include <hip/hip_cooperative_groups.h>
#include <cstdio>
namespace cg = cooperative_groups;

typedef unsigned short u16;
using bf16x8 = __attribute__((ext_vector_type(8))) short;
using f32x4 = __attribute__((ext_vector_type(4))) float;
using f32x16 = __attribute__((ext_vector_type(16))) float;
#define DI __device__ __forceinline__

constexpr int DM = 1024, SEQ = 8192, MR = 16384, NMETA = 16, MALL = MR + NMETA, MPAD = 16640;
constexpr int DFF = 2816, DEPTH = 4;
constexpr int NTHR = 512;
#define DUP_CONV 0
#define DUP_ATTN 0
#define DUP_GU 0
#define DUP_SKINNY 0
constexpr float EPS = 1e-6f;

constexpr size_t al256(size_t x) { return (x + 255) & ~(size_t)255; }
constexpr size_t WS_XN = 0;
constexpr size_t WS_G = WS_XN + al256((size_t)MPAD * 1024 * 2);
constexpr size_t G_BYTES = (size_t)MPAD * DFF * 2;
constexpr size_t WS_WGU = WS_G + al256(G_BYTES);
constexpr size_t WGU_ONE = (size_t)2 * DFF * 1024 * 2;
constexpr size_t WS_WD = WS_WGU + 8 * WGU_ONE;
constexpr size_t WD_ONE = (size_t)1024 * DFF * 2;
constexpr size_t WS_WPOOL = WS_WD + 8 * WD_ONE;
constexpr size_t WS_WDKV = WS_WPOOL + (size_t)8 * 65536 * 2;
constexpr size_t WS_WUKV = WS_WDKV + (size_t)512 * 1024 * 2;
constexpr size_t WS_WDQ = WS_WUKV + (size_t)1024 * 256 * 2;
constexpr size_t WS_WUQ = WS_WDQ + (size_t)2 * 512 * 1024 * 2;
constexpr size_t WS_WO = WS_WUQ + (size_t)2 * 768 * 384 * 2;
constexpr size_t WS_KF = WS_WO + (size_t)2 * 1024 * 512 * 2;
constexpr size_t WS_LO = WS_KF;
constexpr size_t WS_VT = WS_KF + (size_t)2 * 8 * 8192 * 96 * 2;
constexpr size_t WS_KM = WS_VT + (size_t)2 * 8 * 64 * 8192 * 2;
constexpr size_t WS_VM = WS_KM + (size_t)8 * 64 * 96 * 2;
constexpr size_t WS_HM = WS_VM + (size_t)8 * 64 * 64 * 2;
constexpr size_t WS_ROPE = WS_HM + (size_t)16 * 1024 * 4;
constexpr size_t WS_SS = WS_ROPE + al256((size_t)8208 * 16 * 8);
constexpr int NSLOT = 16, SSLD = 16512, SLOT_Q = 13, SLOT_KV = 15;
constexpr size_t WS_CKV = WS_SS + (size_t)NSLOT * SSLD * 4;
constexpr size_t WS_BAR = WS_CKV + al256((size_t)MPAD * 256 * 2);
constexpr size_t WS_END = WS_BAR + 16384;
constexpr size_t GA_P = 0;
constexpr size_t GA_CQ = 0;
constexpr size_t GA_CQN = al256((size_t)MPAD * 384 * 4);
constexpr size_t GA_Q = GA_CQN + al256((size_t)MPAD * 384 * 2);
constexpr size_t GA_O = GA_Q + al256((size_t)MPAD * 768 * 2);
static_assert(GA_O + (size_t)MPAD * 512 * 2 <= G_BYTES, "alias overflow");
static_assert((size_t)MPAD * 1024 * 2 <= (size_t)2 * 8 * 8192 * 96 * 2 + (size_t)2 * 8 * 64 * 8192 * 2, "LO must fit the old K/V region");
constexpr size_t KF_ELEMS = (size_t)2 * 8 * 8192 * 96;
static_assert((KF_ELEMS + (size_t)2 * 8 * 64 * 8192) * 2 <= (size_t)MR * DM * 4, "K/V must fit d_out");

struct Params { const float* in[23]; float* out; unsigned char* ws; };
typedef const __attribute__((address_space(4))) Params* PP;
__device__ __forceinline__ PP launder(PP q) {
  unsigned long long v = (unsigned long long)q;
  unsigned lo = __builtin_amdgcn_readfirstlane((unsigned)v), hi = __builtin_amdgcn_readfirstlane((unsigned)(v >> 32));
  asm volatile("" : "+s"(lo), "+s"(hi));
  return (PP)(((unsigned long long)hi << 32) | lo);
}

__device__ __forceinline__ int ogdim() { int g = __builtin_amdgcn_readfirstlane(gridDim.x); asm volatile("" : "+s"(g)); return g; }
__device__ __forceinline__ int obid() { int b = __builtin_amdgcn_readfirstlane(blockIdx.x); asm volatile("" : "+s"(b)); return b; }
__device__ __forceinline__ int otid() { int t = threadIdx.x; asm volatile("" : "+v"(t)); return t; }
DI u16 f2bf(float x) { return __builtin_bit_cast(u16, (__bf16)x); }
DI float bf2f(u16 v) { return __uint_as_float(((unsigned)v) << 16); }
DI float xhalf_max(float v) {
  const unsigned u = __float_as_uint(v);
  const auto r = __builtin_amdgcn_permlane32_swap(u, u, false, false);
  return fmaxf(__uint_as_float(r[0]), __uint_as_float(r[1]));
}
DI float xhalf_sum(float v) {
  const unsigned u = __float_as_uint(v);
  const auto r = __builtin_amdgcn_permlane32_swap(u, u, false, false);
  return __uint_as_float(r[0]) + __uint_as_float(r[1]);
}
DI float wave_sum(float v) {
  for (int o = 32; o > 0; o >>= 1) v += __shfl_xor(v, o);
  return v;
}
DI float silu_mul(float g, float u) { return g * __builtin_amdgcn_rcpf(1.f + __expf(-g)) * u; }
DI int row_pos(int row) { return row < MR ? (row & (SEQ - 1)) + NMETA : row - MR; }
DI int permt(int t) { return (t & ~12) | ((t & 4) << 1) | ((t & 8) >> 1); }

DI f32x4 hl_sum(unsigned h01, unsigned h23, unsigned l01, unsigned l23) {
  f32x4 r;
  r[0] = __uint_as_float(h01 << 16) + __uint_as_float(l01 << 16);
  r[1] = __uint_as_float(h01 & 0xffff0000u) + __uint_as_float(l01 & 0xffff0000u);
  r[2] = __uint_as_float(h23 << 16) + __uint_as_float(l23 << 16);
  r[3] = __uint_as_float(h23 & 0xffff0000u) + __uint_as_float(l23 & 0xffff0000u);
  return r;
}
DI void hl_split(f32x4 h, ushort4& hi, ushort4& lo) {
  hi = (ushort4){f2bf(h[0]), f2bf(h[1]), f2bf(h[2]), f2bf(h[3])};
  lo.x = f2bf(h[0] - bf2f(hi.x)); lo.y = f2bf(h[1] - bf2f(hi.y)); lo.z = f2bf(h[2] - bf2f(hi.z)); lo.w = f2bf(h[3] - bf2f(hi.w));
}
DI float* hrow_ptr(float* Hr, float* Hm, int row) { return row < MR ? Hr + (size_t)row * DM : Hm + (size_t)(row - MR) * DM; }
DI float rs_of(const float* ss, int row, float invn) { return rsqrtf(ss[row] * invn + EPS); }
DI ushort4 pk4(f32x4 v) { ushort4 o; o.x = f2bf(v[0]); o.y = f2bf(v[1]); o.z = f2bf(v[2]); o.w = f2bf(v[3]); return o; }
DI void row_ss_add(float* ss, int row, float part, bool valid) {
  part += __shfl_xor(part, 16); part += __shfl_xor(part, 32);
  if (valid && (__lane_id() < 16)) atomicAdd(ss + row, part);
}
DI f32x4 swiglu4(f32x4 g, f32x4 u, float r) {
  const float a = -1.4426950408889634f * r, b = r * r;
  const f32x4 t = g * a;
  f32x4 d;
  d[0] = __builtin_amdgcn_rcpf(1.f + __builtin_amdgcn_exp2f(t[0])); d[1] = __builtin_amdgcn_rcpf(1.f + __builtin_amdgcn_exp2f(t[1]));
  d[2] = __builtin_amdgcn_rcpf(1.f + __builtin_amdgcn_exp2f(t[2])); d[3] = __builtin_amdgcn_rcpf(1.f + __builtin_amdgcn_exp2f(t[3]));
  return (g * u) * (d * b);
}
struct EpiSwiglu {
  static constexpr bool GU = true, PERM = true;
  u16* G; const float* ssin;
  DI void colpre(int, f32x4&, f32x4&) const {}
  DI void pre(int row, int, float& r, f32x4&, f32x4&) const { r = ssin[row]; }
  DI void op(int row, int col, f32x4 g, f32x4 u, float r) const {
    r = rsqrtf(r * (1.f / DM) + EPS);
    *(ushort4*)(G + (size_t)row * DFF + col) = pk4(swiglu4(g, u, r));
  }
  DI void op8(int row, int col, f32x4 g0, f32x4 u0, f32x4 g1, f32x4 u1, float r) const {
    r = rsqrtf(r * (1.f / DM) + EPS);
    const ushort4 a = pk4(swiglu4(g0, u0, r)), b = pk4(swiglu4(g1, u1, r));
    bf16x8 o = {(short)a.x, (short)a.y, (short)a.z, (short)a.w, (short)b.x, (short)b.y, (short)b.z, (short)b.w};
    *(bf16x8*)(G + (size_t)row * DFF + col) = o;
  }
};
struct EpiNull {
  static constexpr bool GU = true, PERM = true;
  u16* G;
  DI void colpre(int, f32x4&, f32x4&) const {}
  DI void pre(int, int, float&, f32x4&, f32x4&) const {}
  DI void op(int row, int col, f32x4 g, f32x4 u, float) const { if (g[0] + u[1] + g[2] + u[3] == 12345.678f) G[(size_t)row * DFF + col] = 1; }
  DI void op8(int row, int col, f32x4 g, f32x4 u, f32x4, f32x4, float) const { if (g[0] + u[1] + g[2] + u[3] == 12345.678f) G[(size_t)row * DFF + col] = 1; }
};
template <bool HAS_CS>
struct EpiResidT {
  static constexpr bool GU = false, PERM = true;
  static constexpr int BATCH_ROWS = HAS_CS ? 2 : 4;
  u16* HI; u16* LO; float* ssout; const float* cs; float scale;
  template <int D1> DI void colpre(int col, f32x4& c0, f32x4& c1) const {
    c0 = (f32x4){scale, scale, scale, scale}; c1 = c0;
    if (HAS_CS) { c0 *= *(const f32x4*)(cs + col); c1 *= *(const f32x4*)(cs + col + D1); }
  }
  template <int D1> DI void pre(int row, int col, float&, f32x4& x0, f32x4& x1) const {
    const size_t o = (size_t)row * DM + col;
    if (D1 == 4) { x0 = *(const f32x4*)(HI + o); x1 = *(const f32x4*)(LO + o); }
    else {
      const uint2 a = *(const uint2*)(HI + o), b = *(const uint2*)(LO + o), c = *(const uint2*)(HI + o + D1), d = *(const uint2*)(LO + o + D1);
      x0 = (f32x4){__uint_as_float(a.x), __uint_as_float(a.y), __uint_as_float(b.x), __uint_as_float(b.y)};
      x1 = (f32x4){__uint_as_float(c.x), __uint_as_float(c.y), __uint_as_float(d.x), __uint_as_float(d.y)};
    }
  }
  template <int D1> DI void op(int row, int col, f32x4 v0, f32x4 v1, float, f32x4 x0, f32x4 x1, f32x4 c0, f32x4 c1) const {
    const size_t o = (size_t)row * DM + col;
    f32x4 h0, h1;
    if (D1 == 4) {
      h0 = hl_sum(__float_as_uint(x0[0]), __float_as_uint(x0[1]), __float_as_uint(x1[0]), __float_as_uint(x1[1])) + c0 * v0;
      h1 = hl_sum(__float_as_uint(x0[2]), __float_as_uint(x0[3]), __float_as_uint(x1[2]), __float_as_uint(x1[3])) + c1 * v1;
    } else {
      h0 = hl_sum(__float_as_uint(x0[0]), __float_as_uint(x0[1]), __float_as_uint(x0[2]), __float_as_uint(x0[3])) + c0 * v0;
      h1 = hl_sum(__float_as_uint(x1[0]), __float_as_uint(x1[1]), __float_as_uint(x1[2]), __float_as_uint(x1[3])) + c1 * v1;
    }
    ushort4 ha, la, hb, lb;
    hl_split(h0, ha, la); hl_split(h1, hb, lb);
    if (D1 == 4) {
      const bf16x8 hv = {(short)ha.x, (short)ha.y, (short)ha.z, (short)ha.w, (short)hb.x, (short)hb.y, (short)hb.z, (short)hb.w};
      const bf16x8 lv = {(short)la.x, (short)la.y, (short)la.z, (short)la.w, (short)lb.x, (short)lb.y, (short)lb.z, (short)lb.w};
      *(bf16x8*)(HI + o) = hv; *(bf16x8*)(LO + o) = lv;
    } else {
      *(ushort4*)(HI + o) = ha; *(ushort4*)(LO + o) = la; *(ushort4*)(HI + o + D1) = hb; *(ushort4*)(LO + o + D1) = lb;
    }
    const f32x4 q = h0 * h0 + h1 * h1;
    row_ss_add(ssout, row, q[0] + q[1] + q[2] + q[3], true);
  }
};
struct EpiDQ {
  static constexpr int BATCH_ROWS = 4;
  static constexpr bool GU = false, PERM = true;
  u16* CB; const float* ssin; float* ssout;
  template <int D1> DI void colpre(int, f32x4&, f32x4&) const {}
  template <int D1> DI void pre(int row, int, float& r, f32x4&, f32x4&) const { r = ssin[row]; }
  template <int D1> DI void op(int row, int col, f32x4 v0, f32x4 v1, float r, f32x4, f32x4, f32x4, f32x4) const {
    r = rsqrtf(r * (1.f / DM) + EPS);
    const bool ok = col < 384;
    v0 *= r; v1 *= r;
    if (ok) { *(ushort4*)(CB + (size_t)row * 384 + col) = pk4(v0); *(ushort4*)(CB + (size_t)row * 384 + col + D1) = pk4(v1); }
    const f32x4 q = v0 * v0 + v1 * v1;
    row_ss_add(ssout, row, ok ? q[0] + q[1] + q[2] + q[3] : 0.f, ok);
  }
};
struct EpiDKV {
  static constexpr int BATCH_ROWS = 4;
  static constexpr bool GU = false, PERM = false;
  u16* CB; const float* ssin; float* ssout; const float* rope; u16* Kf; u16* Km;
  template <int D1> DI void colpre(int, f32x4&, f32x4&) const {}
  template <int D1> DI void pre(int row, int col, float& r, f32x4& x0, f32x4& x1) const {
    r = ssin[row];
    if ((col & ~31) == 256) { const float* rp = rope + (size_t)(row_pos(row) * 16 + (col & 15)) * 2; x0 = *(const f32x4*)rp; x1 = *(const f32x4*)(rp + 4); }
  }
  template <int D1> DI void op(int row, int col, f32x4 v0, f32x4 v1, float r, f32x4 ra, f32x4 rb, f32x4, f32x4) const {
    static_assert(D1 == 16, "rotary pairs are 16 columns apart");
    r = rsqrtf(r * (1.f / DM) + EPS);
    v0 *= r; v1 *= r;
    const bool ok = col < 256;
    if (ok) { *(ushort4*)(CB + (size_t)row * 256 + col) = pk4(v0); *(ushort4*)(CB + (size_t)row * 256 + col + 16) = pk4(v1); }
    const f32x4 q = v0 * v0 + v1 * v1;
    row_ss_add(ssout, row, ok ? q[0] + q[1] + q[2] + q[3] : 0.f, ok);
    if ((col & ~31) == 256) {
      const f32x4 c = {ra[0], ra[2], rb[0], rb[2]}, s = {ra[1], ra[3], rb[1], rb[3]};
      const ushort4 o1 = pk4(v0 * c - v1 * s), o2 = pk4(v1 * c + v0 * s);
      const int i0 = col & 15;
      for (int h = 0; h < 8; ++h) {
        u16* kd = row < MR ? Kf + ((size_t)((row >> 13) * 8 + h) * SEQ + (row & (SEQ - 1))) * 96
                           : Km + (h * 64 + (row - MR)) * 96;
        *(ushort4*)(kd + 64 + i0) = o1; *(ushort4*)(kd + 80 + i0) = o2;
      }
    }
  }
};
struct EpiQ {
  static constexpr int BATCH_ROWS = 4;
  static constexpr bool GU = false, PERM = false;
  u16* Q; const float* rope; const float* ssin; float qs;
  template <int D1> DI void colpre(int, f32x4&, f32x4&) const {}
  template <int D1> DI void pre(int row, int col, float& r, f32x4& x0, f32x4& x1) const {
    r = ssin[row];
    if (((col & ~31) % 96) == 64) { const float* rp = rope + (size_t)(row_pos(row) * 16 + (col & 15)) * 2; x0 = *(const f32x4*)rp; x1 = *(const f32x4*)(rp + 4); }
  }
  template <int D1> DI void op(int row, int col, f32x4 v0, f32x4 v1, float r, f32x4 ra, f32x4 rb, f32x4, f32x4) const {
    static_assert(D1 == 16, "rotary pairs are 16 columns apart");
    r = rsqrtf(r * (1.f / 384.f) + EPS) * qs;
    v0 *= r; v1 *= r;
    if (((col & ~31) % 96) == 64) {
      const f32x4 c = {ra[0], ra[2], rb[0], rb[2]}, s = {ra[1], ra[3], rb[1], rb[3]};
      const f32x4 o1 = v0 * c - v1 * s, o2 = v1 * c + v0 * s;
      v0 = o1; v1 = o2;
    }
    *(ushort4*)(Q + (size_t)row * 768 + col) = pk4(v0);
    *(ushort4*)(Q + (size_t)row * 768 + col + 16) = pk4(v1);
  }
};
struct EpiKV {
  static constexpr int BATCH_ROWS = 4;
  static constexpr bool GU = false, PERM = true;
  u16 *Kf, *Vt, *Km, *Vm; const float* ssin;
  template <int D1> DI void colpre(int, f32x4&, f32x4&) const {}
  template <int D1> DI void pre(int row, int, float& r, f32x4&, f32x4&) const { r = ssin[row]; }
  DI void one(int row, int col, f32x4 v) const {
    if (col < 512) {
      const int h = col >> 6, d = col & 63;
      u16* kd = row < MR ? Kf + ((size_t)((row >> 13) * 8 + h) * SEQ + (row & (SEQ - 1))) * 96 + d
                         : Km + (h * 64 + (row - MR)) * 96 + d;
      *(ushort4*)kd = pk4(v);
    } else {
      const int c = col - 512, h = c >> 6, dv = c & 63;
      u16* vd = row < MR ? Vt + ((size_t)((row >> 13) * 8 + h) * 64 + dv) * SEQ + permt(row & (SEQ - 1))
                         : Vm + (h * 64 + dv) * 64 + permt(row - MR);
      const int st = row < MR ? SEQ : 64;
      vd[0] = f2bf(v[0]); vd[st] = f2bf(v[1]); vd[2 * st] = f2bf(v[2]); vd[3 * st] = f2bf(v[3]);
    }
  }
  template <int D1> DI void op(int row, int col, f32x4 v0, f32x4 v1, float r, f32x4, f32x4, f32x4, f32x4) const {
    r = rsqrtf(r * (1.f / 256.f) + EPS);
    one(row, col, v0 * r); one(row, col + D1, v1 * r);
  }
};

#define LAS __attribute__((address_space(3)))
constexpr int BM = 256, BK = 64, HALF = 128, HTB = HALF * BK * 2, SHM_B = 8 * HTB;
DI int lds_byte(int r, int c) {
  const int st = (r >> 4) * 2 + (c >> 5), rr = r & 15, cc = c & 31, ob = rr * 64 + cc * 2;
  return st * 1024 + (ob ^ (((ob >> 9) & 1) << 5));
}
DI int perm32(int rho) { const int n = rho >> 4, i = rho & 15; return 8 * (i >> 2) + 4 * n + (i & 3); }
DI void stage_rc(int b, int& R, int& C) {
  const int st = b / 1024, sb = b % 1024, swz = sb ^ (((sb >> 9) & 1) << 5);
  R = (st >> 1) * 16 + swz / 64; C = (st & 1) * 32 + (swz % 64) / 2;
}
struct Gemm { const u16* A; const u16* Bt; int lda, ldb, K, nN, a_pn_el, boff; };
DI bool unit_next(int i, int nN, int boff, int& pm, int& pn) {
  const int nM = MR / BM, nwg = nM * nN, G = gridDim.x;
  const long L = (long)i * G + (int)(((unsigned)obid() + (unsigned)boff) % (unsigned)G); if (L >= nwg) return false;
  int wgid = (int)L; { const int q = nwg / 8, r = nwg % 8, xcd = wgid % 8, off = wgid / 8; wgid = (xcd < r ? xcd * (q + 1) : r * (q + 1) + (xcd - r) * q) + off; }
  const int WGM = nN >= 8 ? 4 : 8;
  const int nig = WGM * nN, gid = wgid / nig, fm = gid * WGM, gsz = (nM - fm) < WGM ? (nM - fm) : WGM;
  pm = fm + ((wgid % nig) % gsz); pn = (wgid % nig) / gsz; return true;
}

template <class Epi>
__device__ __forceinline__ void gemm_phase(const Gemm g, const Epi& E) {
  extern __shared__ __attribute__((aligned(16))) unsigned char shm_raw[];
  LAS unsigned char* lds = (LAS unsigned char*)shm_raw;
  const int tid = otid(), wid = __builtin_amdgcn_readfirstlane(tid >> 6), lane = tid & 63, wr = wid >> 2, wc = wid & 3, fr = lane & 15, fq = lane >> 4;
  const int K = g.K, nt = K / BK;
  unsigned voffA[2], voffB[2];
#pragma unroll
  for (int i = 0; i < 2; ++i) { int R, C; stage_rc(tid * 16 + i * 8192, R, C);
    const int Rb = Epi::PERM ? ((R & ~31) + perm32(R & 31)) : R;
    voffA[i] = (unsigned)(R * g.lda + C) * 2u; voffB[i] = (unsigned)(Rb * g.ldb + C) * 2u; }
  const size_t kstep = (size_t)(BK * 2);
  const size_t hstepA = (size_t)HALF * g.lda * 2, hstepB = (size_t)HALF * g.ldb * 2;
  const unsigned ldsw = (unsigned)wid * 1024u;
  const int aoff = lds_byte(wr * 64 + fr, fq * 8), boff = lds_byte(wc * 32 + fr, fq * 8);
#define PG8_SA(b, h) (((b) * 2 + (h)) * HTB)
#define PG8_SB(b, h) ((4 + (b) * 2 + (h)) * HTB)
#define PG8_STAGE(bufoff, gbase, voff) do { _Pragma("unroll") for (int _i = 0; _i < 2; ++_i) \
    __builtin_amdgcn_global_load_lds((const unsigned*)((const char*)(gbase) + (voff)[_i]), (LAS unsigned*)(lds + (bufoff) + ldsw + _i * 8192), 16, 0, 0); } while (0)
#define PG8_LDA(dst, b, h) do { _Pragma("unroll") for (int m = 0; m < 4; ++m) _Pragma("unroll") for (int k = 0; k < 2; ++k) dst[m][k] = *(const LAS bf16x8*)(lds + PG8_SA(b, h) + aoff + m * 2048 + k * 1024); } while (0)
#define PG8_LDB(dst, b, h) do { _Pragma("unroll") for (int n = 0; n < 2; ++n) _Pragma("unroll") for (int k = 0; k < 2; ++k) dst[n][k] = *(const LAS bf16x8*)(lds + PG8_SB(b, h) + boff + n * 2048 + k * 1024); } while (0)
#define PG8_MMA(ai, bj, At_, Bt_) do { __builtin_amdgcn_s_setprio(1); _Pragma("unroll") for (int m = 0; m < 4; ++m) _Pragma("unroll") for (int n = 0; n < 2; ++n) _Pragma("unroll") for (int k = 0; k < 2; ++k) \
    acc[ai][bj][m][n] = __builtin_amdgcn_mfma_f32_16x16x32_bf16(Bt_[n][k], At_[m][k], acc[ai][bj][m][n], 0, 0, 0); __builtin_amdgcn_s_setprio(0); } while (0)
#define PG8_WAIT_V(n) asm volatile("s_waitcnt vmcnt(" #n ")" ::: "memory")
#define PG8_WAIT_L(n) asm volatile("s_waitcnt lgkmcnt(" #n ")" ::: "memory")
#define PG8_BAR __builtin_amdgcn_s_barrier()
#define PG8_SCHED __builtin_amdgcn_sched_barrier(0)
  int cpm, cpn, npm = 0, npn = 0, ui = 0;
  if (!unit_next(0, g.nN, g.boff, cpm, cpn)) return;
  f32x4 acc[2][2][4][2];
#pragma unroll
  for (int a = 0; a < 2; ++a)
#pragma unroll
    for (int b = 0; b < 2; ++b)
#pragma unroll
      for (int m = 0; m < 4; ++m)
#pragma unroll
        for (int n = 0; n < 2; ++n) acc[a][b][m][n] = (f32x4){0.f, 0.f, 0.f, 0.f};
  bf16x8 At[4][2], B0[2][2], B1[2][2];
  const char* cA = (const char*)(g.A + (size_t)cpn * g.a_pn_el) + (size_t)cpm * 2 * hstepA;
  const char* cB = (const char*)g.Bt + (size_t)cpn * 2 * hstepB;
  PG8_STAGE(PG8_SB(0, 0), cB, voffB); PG8_STAGE(PG8_SA(0, 0), cA, voffA); PG8_STAGE(PG8_SB(0, 1), cB + hstepB, voffB); PG8_STAGE(PG8_SA(0, 1), cA + hstepA, voffA);
  if (wr == 1) PG8_BAR;
  PG8_WAIT_V(4); PG8_BAR;
  PG8_STAGE(PG8_SB(1, 0), cB + kstep, voffB); PG8_STAGE(PG8_SA(1, 0), cA + kstep, voffA); PG8_STAGE(PG8_SB(1, 1), cB + hstepB + kstep, voffB);
  PG8_WAIT_V(6); PG8_BAR;
  for (;;) {
    const bool has_next = unit_next(ui + 1, g.nN, g.boff, npm, npn);
    const char* nA = has_next ? (const char*)(g.A + (size_t)npn * g.a_pn_el) + (size_t)npm * 2 * hstepA : cA;
    const char* nB = has_next ? (const char*)g.Bt + (size_t)npn * 2 * hstepB : cB;
#pragma unroll 1
    for (int t = 0; t < nt; t += 2) {
      const bool last = (t == nt - 2);
      const char* a1 = cA + (size_t)(t + 1) * kstep;
      const char* a2 = last ? nA : cA + (size_t)(t + 2) * kstep; const char* b2 = last ? nB : cB + (size_t)(t + 2) * kstep;
      const char* a3 = a2 + kstep; const char* b3 = b2 + kstep;
      PG8_LDB(B0, 0, 0); PG8_SCHED; PG8_LDA(At, 0, 0); PG8_STAGE(PG8_SA(1, 1), a1 + hstepA, voffA);
      PG8_WAIT_L(8); PG8_BAR; PG8_WAIT_L(0); PG8_MMA(0, 0, At, B0); PG8_BAR; PG8_SCHED;
      PG8_LDB(B1, 0, 1); PG8_STAGE(PG8_SB(0, 0), b2, voffB);
      PG8_BAR; PG8_WAIT_L(0); PG8_MMA(0, 1, At, B1); PG8_BAR;
      PG8_LDA(At, 0, 1); PG8_STAGE(PG8_SA(0, 0), a2, voffA);
      PG8_BAR; PG8_WAIT_L(0); PG8_MMA(1, 0, At, B0); PG8_BAR; PG8_SCHED;
      PG8_STAGE(PG8_SB(0, 1), b2 + hstepB, voffB);
      PG8_WAIT_V(6); PG8_BAR; PG8_MMA(1, 1, At, B1); PG8_BAR;
      PG8_LDB(B0, 1, 0); PG8_SCHED; PG8_LDA(At, 1, 0); PG8_STAGE(PG8_SA(0, 1), a2 + hstepA, voffA);
      PG8_WAIT_L(8); PG8_BAR; PG8_WAIT_L(0); PG8_MMA(0, 0, At, B0); PG8_BAR; PG8_SCHED;
      PG8_LDB(B1, 1, 1); PG8_STAGE(PG8_SB(1, 0), b3, voffB);
      PG8_BAR; PG8_WAIT_L(0); PG8_MMA(0, 1, At, B1); PG8_BAR;
      PG8_LDA(At, 1, 1); PG8_STAGE(PG8_SA(1, 0), a3, voffA);
      PG8_BAR; PG8_WAIT_L(0); PG8_MMA(1, 0, At, B0); PG8_BAR; PG8_SCHED;
      PG8_STAGE(PG8_SB(1, 1), b3 + hstepB, voffB);
      PG8_WAIT_V(6); PG8_BAR; PG8_MMA(1, 1, At, B1); PG8_BAR;
    }
    {
      const int t2 = otid(), wid2 = __builtin_amdgcn_readfirstlane(t2 >> 6), wr2 = wid2 >> 2, wc2 = wid2 & 3, fr2 = t2 & 15, fq2 = (t2 & 63) >> 4;
      const int row0 = cpm * BM + wr2 * 64 + fr2;
      const f32x4 z4 = {0.f, 0.f, 0.f, 0.f};
      constexpr int D1 = Epi::PERM ? 4 : 16, FQ = Epi::PERM ? 8 : 4;
      if constexpr (Epi::GU) {
        const int col0 = cpn * HALF + wc2 * 32 + FQ * fq2;
#pragma unroll
        for (int ai = 0; ai < 2; ++ai) {
          float rr[4]; f32x4 xa = z4, xb_ = z4;
#pragma unroll
          for (int m = 0; m < 4; ++m) { rr[m] = 0.f; E.pre(row0 + ai * HALF + m * 16, col0, rr[m], xa, xb_); }
#pragma unroll
          for (int m = 0; m < 4; ++m)
            E.op8(row0 + ai * HALF + m * 16, col0, acc[ai][0][m][0], acc[ai][1][m][0], acc[ai][0][m][1], acc[ai][1][m][1], rr[m]);
        }
      } else {
        const int col0 = cpn * BM + wc2 * 32 + FQ * fq2;
        f32x4 c0[2], c1[2];
#pragma unroll
        for (int bj = 0; bj < 2; ++bj) { c0[bj] = z4; c1[bj] = z4; E.template colpre<D1>(col0 + bj * HALF, c0[bj], c1[bj]); }
        constexpr int BR = Epi::BATCH_ROWS;
#pragma unroll
        for (int am = 0; am < 8 / BR; ++am) {
          const int r0b = am * BR;
          float rr[BR][2]; f32x4 x0[BR][2], x1[BR][2];
#pragma unroll
          for (int m = 0; m < BR; ++m)
#pragma unroll
            for (int bj = 0; bj < 2; ++bj) { const int rs = r0b + m; rr[m][bj] = 0.f; x0[m][bj] = z4; x1[m][bj] = z4;
              E.template pre<D1>(row0 + (rs >> 2) * HALF + (rs & 3) * 16, col0 + bj * HALF, rr[m][bj], x0[m][bj], x1[m][bj]); }
#pragma unroll
          for (int m = 0; m < BR; ++m)
#pragma unroll
            for (int bj = 0; bj < 2; ++bj) { const int rs = r0b + m;
              E.template op<D1>(row0 + (rs >> 2) * HALF + (rs & 3) * 16, col0 + bj * HALF, acc[rs >> 2][bj][rs & 3][0], acc[rs >> 2][bj][rs & 3][1], rr[m][bj], x0[m][bj], x1[m][bj], c0[bj], c1[bj]); }
        }
      }
    }
    if (!has_next) break;
#pragma unroll
    for (int a = 0; a < 2; ++a)
#pragma unroll
      for (int b = 0; b < 2; ++b)
#pragma unroll
        for (int m = 0; m < 4; ++m)
#pragma unroll
          for (int n = 0; n < 2; ++n) acc[a][b][m][n] = (f32x4){0.f, 0.f, 0.f, 0.f};
    cpm = npm; cpn = npn; cA = nA; cB = nB; ++ui;
  }
  PG8_WAIT_V(0);
  if (wr == 0) PG8_BAR;
  PG8_BAR;
#undef PG8_SA
#undef PG8_SB
#undef PG8_STAGE
#undef PG8_LDA
#undef PG8_LDB
#undef PG8_MMA
}

template <class Epi>
__device__ __forceinline__ void skinny(const Gemm g, int nitems, const Epi& E, int first_block = 0) {
  extern __shared__ __attribute__((aligned(16))) float sk_red[];
  const int tid = otid(), wave = __builtin_amdgcn_readfirstlane(tid >> 6), lane = tid & 63, G = gridDim.x;
  const int fr = lane & 15, fq = lane >> 4;
  const int nks = g.K >> 5;
  for (int it = (first_block ? (int)blockIdx.x - first_block + (blockIdx.x < (unsigned)first_block ? (1 << 28) : 0) : G - 1 - (int)blockIdx.x); it < nitems; it += (first_block ? G - first_block : G)) {
    int r0, r1, col, pn;
    if (Epi::GU) { pn = it >> 3; const int w = (it & 7) * 16; r0 = pn * 256 + w; r1 = r0 + 128; col = pn * 128 + w; }
    else { r0 = it * 32; r1 = r0 + 16; col = it * 32; pn = col >> 8; }
    const u16* ap = g.A + (size_t)pn * g.a_pn_el + (size_t)(MR + fr) * g.lda + fq * 8;
    const u16* b0p = g.Bt + (size_t)(r0 + fr) * g.ldb + fq * 8;
    const u16* b1p = g.Bt + (size_t)(r1 + fr) * g.ldb + fq * 8;
    f32x4 a0 = {0.f, 0.f, 0.f, 0.f}, a1 = {0.f, 0.f, 0.f, 0.f};
#pragma unroll 4
    for (int ks = wave; ks < nks; ks += 8) {
      const int k = ks * 32;
      const bf16x8 a = *(const bf16x8*)(ap + k);
      const bf16x8 b0 = *(const bf16x8*)(b0p + k);
      const bf16x8 b1 = *(const bf16x8*)(b1p + k);
      a0 = __builtin_amdgcn_mfma_f32_16x16x32_bf16(b0, a, a0, 0, 0, 0);
      a1 = __builtin_amdgcn_mfma_f32_16x16x32_bf16(b1, a, a1, 0, 0, 0);
    }
    __syncthreads();
    float* my = sk_red + (wave * 64 + lane) * 8;
    *(f32x4*)my = a0; *(f32x4*)(my + 4) = a1;
    __syncthreads();
    if (wave == 0) {
      f32x4 s0 = {0.f, 0.f, 0.f, 0.f}, s1 = {0.f, 0.f, 0.f, 0.f};
#pragma unroll
      for (int w = 0; w < 8; ++w) { s0 += *(const f32x4*)(sk_red + (w * 64 + lane) * 8); s1 += *(const f32x4*)(sk_red + (w * 64 + lane) * 8 + 4); }
      float r = 0.f; f32x4 x0 = {0.f, 0.f, 0.f, 0.f}, x1 = x0, c0 = x0, c1 = x0;
      if constexpr (Epi::GU) { E.pre(MR + fr, col + 4 * fq, r, x0, x1); E.op(MR + fr, col + 4 * fq, s0, s1, r); }
      else {
        E.template colpre<16>(col + 4 * fq, c0, c1);
        E.template pre<16>(MR + fr, col + 4 * fq, r, x0, x1);
        E.template op<16>(MR + fr, col + 4 * fq, s0, s1, r, x0, x1, c0, c1);
      }
    }
  }
  __syncthreads();
}
template <class Epi>
__device__ __forceinline__ void gemm_all(const Gemm g, int n_skinny, const Epi& E, int first_block = 0) {
  gemm_phase<Epi>(g, E);
  skinny<Epi>(g, n_skinny, E, first_block);
}

__device__ __forceinline__ void conv_tile(const float* __restrict__ src, int sld, int c0, int cvalid_end, int k0, int kend,
                          u16* __restrict__ dst, int dld, int r0, const float* __restrict__ gain) {
  extern __shared__ __attribute__((aligned(16))) float ctile[];
  const int tid = otid();
  __syncthreads();
  {
    const int j = tid & 63, i0 = tid >> 6;
    const bool cok = c0 + j < cvalid_end;
    float v[32];
#pragma unroll
    for (int e = 0; e < 32; ++e) {
      const int k = k0 + i0 + e * 8;
      v[e] = (cok && k < kend) ? src[(size_t)k * sld + c0 + j] : 0.f;
    }
    if (gain) {
#pragma unroll
      for (int e = 0; e < 32; ++e) { const int k = k0 + i0 + e * 8; v[e] *= (k < kend) ? gain[k] : 0.f; }
    }
#pragma unroll
    for (int e = 0; e < 32; ++e) ctile[(i0 + e * 8) * 65 + j] = v[e];
  }
  __syncthreads();
  {
    const int j = tid >> 3, ic = tid & 7;
#pragma unroll
    for (int q = 0; q < 4; ++q) {
      const int kk = (q * 8 + ic) * 8;
      if (k0 + kk < kend) {
        bf16x8 v;
#pragma unroll
        for (int e = 0; e < 8; ++e) v[e] = (short)f2bf(ctile[(kk + e) * 65 + j]);
        *(bf16x8*)(dst + (size_t)(r0 + j) * dld + k0 + kk) = v;
      }
    }
  }
}
__device__ __forceinline__ void conv_seg(const float* src, int sld, int c0, int ncols_valid, int ncols_pad, int K, u16* dst, int dld, int r0, const float* gain) {
  const int nct = ncols_pad / 64, nkt = (K + 255) / 256;
  for (int t = blockIdx.x; t < nct * nkt; t += gridDim.x) {
    const int ct = t % nct, kt = t / nct;
    conv_tile(src, sld, c0 + ct * 64, c0 + ncols_valid, kt * 256, K, dst, dld, r0 + ct * 64, gain);
  }
}

__device__ __forceinline__ void conv_ffn(PP p, int f, int t0, int stride, int tbeg = 0, int tend = 528) {
  unsigned char* ws = p->ws;
  const int l = f >> 1, s2 = f & 1;
  for (int t = tbeg + t0; t < tend; t += stride) {
    if (t < 352) {
      const int which = t & 1, n64 = (t >> 1) % 44, kt = (t >> 1) / 44;
      const float* src = p->in[(s2 ? 8 : 3) + which] + (size_t)l * 1024 * DFF;
      u16* dst = (u16*)(ws + WS_WGU + (size_t)f * WGU_ONE);
      conv_tile(src, DFF, n64 * 64, DFF, kt * 256, 1024, dst, 1024, (n64 >> 1) * 256 + which * 128 + (n64 & 1) * 64, p->in[s2 ? 7 : 2] + l * DM);
    } else {
      const int r = t - 352, ct = r % 16, kt = r / 16;
      const float* src = p->in[s2 ? 10 : 5] + (size_t)l * DFF * 1024;
      u16* dst = (u16*)(ws + WS_WD + (size_t)f * WD_ONE);
      conv_tile(src, 1024, ct * 64, 1024, kt * 256, DFF, dst, DFF, ct * 64, nullptr);
    }
  }
  __syncthreads();
}
__device__ __forceinline__ void conv_small(PP p) {
  unsigned char* ws = p->ws;
  for (int t = blockIdx.x; t < 256; t += gridDim.x) {
    const float* src; const float* gain = nullptr; u16* dst; int sld, c0, cend, k0, kend, dld, r0;
    if (t < 32) {
      const int i = t >> 2, ct = t & 3;
      src = p->in[11] + (size_t)i * 65536; sld = 256; c0 = ct * 64; cend = 256; k0 = 0; kend = 256;
      dst = (u16*)(ws + WS_WPOOL) + (size_t)i * 65536; dld = 256; r0 = ct * 64;
    } else if (t < 64) {
      const int r = t - 32, ct = r & 7, kt = r >> 3;
      src = p->in[14]; sld = 288; c0 = ct * 64; cend = 288; k0 = kt * 256; kend = 1024;
      dst = (u16*)(ws + WS_WDKV); dld = 1024; r0 = ct * 64; gain = p->in[13];
    } else if (t < 80) {
      const int r = t - 64, which = r >> 3, ct = r & 7;
      src = p->in[16 + which]; sld = 512; c0 = ct * 64; cend = 512; k0 = 0; kend = 256;
      dst = (u16*)(ws + WS_WUKV); dld = 256; r0 = which * 512 + ct * 64; gain = p->in[15];
    } else {
      const int r = (t - 80) % 88, j = (t - 80) / 88;
      if (r < 32) {
        const int ct = r & 7, kt = r >> 3;
        src = p->in[18] + (size_t)j * 1024 * 384; sld = 384; c0 = ct * 64; cend = 384; k0 = kt * 256; kend = 1024;
        dst = (u16*)(ws + WS_WDQ) + (size_t)j * 512 * 1024; dld = 1024; r0 = ct * 64; gain = p->in[6] + (2 + j) * DM;
      } else if (r < 56) {
        const int q = r - 32, ct = q % 12, kt = q / 12;
        src = p->in[20] + (size_t)j * 384 * 768; sld = 768; c0 = ct * 64; cend = 768; k0 = kt * 256; kend = 384;
        dst = (u16*)(ws + WS_WUQ) + (size_t)j * 768 * 384; dld = 384; r0 = ct * 64; gain = p->in[19] + j * 384;
      } else {
        const int q = r - 56, ct = q & 15, kt = q >> 4;
        src = p->in[21] + (size_t)j * 512 * 1024; sld = 1024; c0 = ct * 64; cend = 1024; k0 = kt * 256; kend = 512;
        dst = (u16*)(ws + WS_WO) + (size_t)j * 1024 * 512; dld = 512; r0 = ct * 64;
      }
    }
    conv_tile(src, sld, c0, cend, k0, kend, dst, dld, r0, gain);
  }
  __syncthreads();
}

template <int MODE>
__device__ __forceinline__ void norm_rows(PP p, const float* __restrict__ gain) {
  const int tid = otid(), wave = tid >> 6, lane = tid & 63;
  u16* HI = (u16*)(p->ws + WS_XN); u16* LO = (u16*)(p->ws + WS_LO);
  float* ss0 = (float*)(p->ws + WS_SS);
  const int nrows = (MODE == 2) ? MR : MALL;
  constexpr int NB = 4;
  const int stride = gridDim.x * 8;
  for (int row0 = blockIdx.x * 8 + wave; row0 < nrows; row0 += NB * stride) {
    f32x4 v[NB][4];
#pragma unroll
    for (int k = 0; k < NB; ++k) {
      const int row = row0 + k * stride;
      if (row < nrows) {
        if (MODE == 1) {
          const float* src = row < MR ? p->in[0] + (size_t)row * DM : p->in[1] + (size_t)(row - MR) * DM;
#pragma unroll
          for (int i = 0; i < 4; ++i) v[k][i] = ((const f32x4*)src)[i * 64 + lane];
        } else {
#pragma unroll
          for (int i = 0; i < 4; ++i) {
            const uint2 a = ((const uint2*)(HI + (size_t)row * DM))[i * 64 + lane], b = ((const uint2*)(LO + (size_t)row * DM))[i * 64 + lane];
            v[k][i] = hl_sum(a.x, a.y, b.x, b.y);
          }
        }
      } else {
#pragma unroll
        for (int i = 0; i < 4; ++i) v[k][i] = (f32x4){0.f, 0.f, 0.f, 0.f};
      }
    }
#pragma unroll
    for (int k = 0; k < NB; ++k) {
      const int row = row0 + k * stride;
      float ss = 0.f;
#pragma unroll
      for (int i = 0; i < 4; ++i) { const f32x4 q = v[k][i] * v[k][i]; ss += q[0] + q[1] + q[2] + q[3]; }
      ss = wave_sum(ss);
      if (row < nrows) {
        if (MODE == 1) {
          if (lane == 0) ss0[row] = ss;
#pragma unroll
          for (int i = 0; i < 4; ++i) {
            ushort4 hi, lo; hl_split(v[k][i], hi, lo);
            ((ushort4*)(HI + (size_t)row * DM))[i * 64 + lane] = hi;
            ((ushort4*)(LO + (size_t)row * DM))[i * 64 + lane] = lo;
          }
        } else {
          const float r = rsqrtf(ss * (1.f / DM) + EPS);
#pragma unroll
          for (int i = 0; i < 4; ++i) {
            const f32x4 g = ((const f32x4*)gain)[i * 64 + lane];
            ((f32x4*)(p->out + (size_t)row * DM))[i * 64 + lane] = v[k][i] * g * r;
          }
        }
      }
    }
  }
}

template <int W>
__device__ __forceinline__ void pool_seg(const u16* __restrict__ HB, const float* __restrict__ ss, const float* __restrict__ gain,
                                         u16* __restrict__ P, int b, int t0, int c8) {
  constexpr int NR = W - 1 + 8;
  bf16x8 v[NR]; float rr[NR];
#pragma unroll
  for (int j = 0; j < NR; ++j) {
    const int q = NMETA + t0 - (W - 1) + j;
    const int r = q >= NMETA ? b * SEQ + q - NMETA : MR + q;
    v[j] = *(const bf16x8*)(HB + (size_t)r * DM + c8 * 8);
    rr[j] = ss[r];
  }
  const f32x4 g0 = *(const f32x4*)(gain + c8 * 8), g1 = *(const f32x4*)(gain + c8 * 8 + 4);
  float S[8];
#pragma unroll
  for (int e = 0; e < 8; ++e) S[e] = 0.f;
#pragma unroll
  for (int j = 0; j < NR; ++j) {
    const float rj = rsqrtf(rr[j] * (1.f / DM) + EPS);
    float u[8];
#pragma unroll
    for (int e = 0; e < 8; ++e) { u[e] = bf2f((u16)v[j][e]) * rj; S[e] += u[e]; }
    if (j >= W - 1) {
      bf16x8 o;
#pragma unroll
      for (int e = 0; e < 8; ++e) o[e] = (short)f2bf((S[e] * (1.f / W) - u[e]) * (e < 4 ? g0[e & 3] : g1[e & 3]));
      *(bf16x8*)(P + (size_t)(b * SEQ + t0 + j - (W - 1)) * DM + c8 * 8) = o;
      const float ro = rsqrtf(rr[j - (W - 1)] * (1.f / DM) + EPS);
#pragma unroll
      for (int e = 0; e < 8; ++e) S[e] -= bf2f((u16)v[j - (W - 1)][e]) * ro;
    }
  }
}
__device__ __forceinline__ void pool_phase(const u16* __restrict__ HB, const float* __restrict__ ss, const float* __restrict__ gain, u16* __restrict__ P) {
  const int nitem = 4 * 2048 * 32;
  for (int i = blockIdx.x * NTHR + otid(); i < nitem; i += gridDim.x * NTHR) {
    const int c = i & 31, bseg = (i >> 5) & 2047, g = i >> 16;
    const int b = bseg >> 10, t0 = (bseg & 1023) * 8, c8 = g * 32 + c;
    if (g == 0) pool_seg<2>(HB, ss, gain, P, b, t0, c8);
    else if (g == 1) pool_seg<4>(HB, ss, gain, P, b, t0, c8);
    else if (g == 2) pool_seg<8>(HB, ss, gain, P, b, t0, c8);
    else pool_seg<16>(HB, ss, gain, P, b, t0, c8);
  }
  for (int idx = blockIdx.x * NTHR + otid(); idx < NMETA * 128; idx += gridDim.x * NTHR) {
    const int pos = idx >> 7, c8 = idx & 127, w = 2 << (c8 >> 5);
    const int cnt = min(w, pos + 1);
    float acc[8], self[8];
#pragma unroll
    for (int e = 0; e < 8; ++e) { acc[e] = 0.f; self[e] = 0.f; }
    bf16x8 v[16]; float rr[16];
#pragma unroll
    for (int j = 0; j < 16; ++j) {
      v[j] = (bf16x8){0, 0, 0, 0, 0, 0, 0, 0}; rr[j] = 1.f;
      if (j < cnt) { const int r = MR + pos - j; v[j] = *(const bf16x8*)(HB + (size_t)r * DM + c8 * 8); rr[j] = ss[r]; }
    }
#pragma unroll
    for (int j = 0; j < 16; ++j) {
      const float rj = (j < cnt) ? rsqrtf(rr[j] * (1.f / DM) + EPS) : 0.f;
#pragma unroll
      for (int e = 0; e < 8; ++e) { const float f = bf2f((u16)v[j][e]) * rj; acc[e] += f; if (j == 0) self[e] = f; }
    }
    const float inv = 1.f / (float)cnt;
    const f32x4 g0 = *(const f32x4*)(gain + c8 * 8), g1 = *(const f32x4*)(gain + c8 * 8 + 4);
    bf16x8 o;
#pragma unroll
    for (int e = 0; e < 8; ++e) o[e] = (short)f2bf((acc[e] * inv - self[e]) * (e < 4 ? g0[e & 3] : g1[e & 3]));
    *(bf16x8*)(P + (size_t)(MR + pos) * DM + c8 * 8) = o;
  }
}

constexpr int KPITCH = 208, VPITCH = 144, KBYTES = 64 * KPITCH, ABUF = KBYTES + 64 * VPITCH;
__device__ __forceinline__ void attn_block(PP p, int b, int h, int qb) {
  extern __shared__ __attribute__((aligned(16))) unsigned char alds[];
  const int tid = otid(), wave = tid >> 6, lane = tid & 63, l32 = lane & 31, hl = lane >> 5;
  const u16* Q = (const u16*)(p->ws + WS_G + GA_Q);
  u16* O = (u16*)(p->ws + WS_G + GA_O);
  const bool meta = qb < 0;
  int qrow, cw, cmax;
  if (!meta) { qrow = b * SEQ + qb * 256 + wave * 32 + l32; cw = qb * 4 + (wave >> 1); cmax = qb * 4 + 3; }
  else { qrow = MR + min(l32, 15); cw = (wave == 0) ? -1 : -2; cmax = -1; }
  bf16x8 qf[6];
  {
    const u16* qp = Q + (size_t)qrow * 768 + h * 96 + hl * 8;
#pragma unroll
    for (int ks = 0; ks < 6; ++ks) qf[ks] = *(const bf16x8*)(qp + ks * 16);
  }
  f32x16 o0, o1;
#pragma unroll
  for (int i = 0; i < 16; ++i) { o0[i] = 0.f; o1[i] = 0.f; }
  float mrun = -1e30f, lsum = 0.f;
  const u16* Kg = (const u16*)p->out + (size_t)((b * 8 + h) * SEQ) * 96;
  const u16* Vg = (const u16*)p->out + KF_ELEMS + (size_t)((b * 8 + h) * 64) * SEQ;
  const u16* Kmg = (const u16*)(p->ws + WS_KM) + h * 64 * 96;
  const u16* Vmg = (const u16*)(p->ws + WS_VM) + h * 64 * 64;
  const int vdv = tid >> 3, vpart = tid & 7;
  const int kw0 = (tid / 12) * KPITCH + (tid % 12) * 16;
  const int kw1 = ((tid + 512) / 12) * KPITCH + ((tid + 512) % 12) * 16;
  const int vw = KBYTES + vdv * VPITCH + vpart * 16;
  uint4 kr0, kr1 = make_uint4(0, 0, 0, 0), vr;
#define ATT_LOAD(kt) do { const uint4* ks_ = (const uint4*)((kt) < 0 ? Kmg : Kg + (size_t)(kt) * 64 * 96); \
    kr0 = ks_[tid]; if (tid < 256) kr1 = ks_[tid + 512]; \
    vr = *(const uint4*)((kt) < 0 ? Vmg + vdv * 64 + vpart * 8 : Vg + (size_t)vdv * SEQ + (kt) * 64 + vpart * 8); } while (0)
#define ATT_WRITE(buf) do { unsigned char* b_ = alds + (buf) * ABUF; *(uint4*)(b_ + kw0) = kr0; if (tid < 256) *(uint4*)(b_ + kw1) = kr1; \
    *(uint4*)(b_ + vw) = vr; } while (0)
  ATT_LOAD(-1);
  ATT_WRITE(0);
  __syncthreads();
  int it = 0;
  for (int kt = -1; kt <= cmax; ++kt, ++it) {
    const int buf = it & 1;
    if (kt < cmax) ATT_LOAD(kt + 1);
    if (kt <= cw) {
      const unsigned char* kb = alds + buf * ABUF;
      const unsigned char* vb = kb + KBYTES;
      f32x16 s0, s1;
#pragma unroll
      for (int i = 0; i < 16; ++i) { s0[i] = 0.f; s1[i] = 0.f; }
#pragma unroll
      for (int ks = 0; ks < 6; ++ks) {
        const bf16x8 k0 = *(const bf16x8*)(kb + l32 * KPITCH + ks * 32 + hl * 16);
        const bf16x8 k1 = *(const bf16x8*)(kb + (32 + l32) * KPITCH + ks * 32 + hl * 16);
        s0 = __builtin_amdgcn_mfma_f32_32x32x16_bf16(k0, qf[ks], s0, 0, 0, 0);
        s1 = __builtin_amdgcn_mfma_f32_32x32x16_bf16(k1, qf[ks], s1, 0, 0, 0);
      }
      if (kt < 0) {
#pragma unroll
        for (int i = 8; i < 16; ++i) s0[i] = -1e30f;
#pragma unroll
        for (int i = 0; i < 16; ++i) s1[i] = -1e30f;
      }
      float mx = s0[0];
#pragma unroll
      for (int i = 1; i < 16; ++i) mx = fmaxf(mx, s0[i]);
#pragma unroll
      for (int i = 0; i < 16; ++i) mx = fmaxf(mx, s1[i]);
      mx = xhalf_max(mx);
      const float mnew = fmaxf(mrun, mx);
      const float alpha = __builtin_amdgcn_exp2f(mrun - mnew);
      mrun = mnew;
      float ps = 0.f;
#pragma unroll
      for (int i = 0; i < 16; ++i) { s0[i] = __builtin_amdgcn_exp2f(s0[i] - mnew); ps += s0[i]; }
#pragma unroll
      for (int i = 0; i < 16; ++i) { s1[i] = __builtin_amdgcn_exp2f(s1[i] - mnew); ps += s1[i]; }
      lsum = lsum * alpha + ps;
#pragma unroll
      for (int i = 0; i < 16; ++i) { o0[i] *= alpha; o1[i] *= alpha; }
#pragma unroll
      for (int jp = 0; jp < 4; ++jp) {
        bf16x8 pf;
#pragma unroll
        for (int e = 0; e < 8; ++e) pf[e] = (short)f2bf((jp < 2) ? s0[(jp & 1) * 8 + e] : s1[(jp & 1) * 8 + e]);
        const bf16x8 v0 = *(const bf16x8*)(vb + l32 * VPITCH + (jp * 16 + hl * 8) * 2);
        const bf16x8 v1 = *(const bf16x8*)(vb + (32 + l32) * VPITCH + (jp * 16 + hl * 8) * 2);
        o0 = __builtin_amdgcn_mfma_f32_32x32x16_bf16(v0, pf, o0, 0, 0, 0);
        o1 = __builtin_amdgcn_mfma_f32_32x32x16_bf16(v1, pf, o1, 0, 0, 0);
        }
    }
    if (kt < cmax) ATT_WRITE(buf ^ 1);
    __syncthreads();
  }
#undef ATT_LOAD
#undef ATT_WRITE
  const float ltot = xhalf_sum(lsum);
  if (cw >= -1 && (!meta || l32 < 16)) {
    const float inv = 1.f / ltot;
    u16* op = O + (size_t)qrow * 512 + h * 64 + 4 * hl;
#pragma unroll
    for (int g4 = 0; g4 < 4; ++g4) {
      ushort4 a, c;
      a.x = f2bf(o0[g4 * 4 + 0] * inv); a.y = f2bf(o0[g4 * 4 + 1] * inv); a.z = f2bf(o0[g4 * 4 + 2] * inv); a.w = f2bf(o0[g4 * 4 + 3] * inv);
      c.x = f2bf(o1[g4 * 4 + 0] * inv); c.y = f2bf(o1[g4 * 4 + 1] * inv); c.z = f2bf(o1[g4 * 4 + 2] * inv); c.w = f2bf(o1[g4 * 4 + 3] * inv);
      *(ushort4*)(op + 8 * g4) = a;
      *(ushort4*)(op + 32 + 8 * g4) = c;
    }
  }
}

__device__ __forceinline__ void attn_phase(PP p) {
  const int G = gridDim.x;
  for (int it = blockIdx.x; it < 256 + 8; it += G) {
    const int nsub = it < 256 ? 2 : 1;
    for (int sub = 0; sub < nsub; ++sub) {
      int b, h, qb;
      if (it < 256) { const int bh = it >> 4, i = it & 15; b = bh >> 3; h = bh & 7; qb = sub ? i : 31 - i; }
      else { b = 0; h = it - 256; qb = -1; }
      attn_block(p, b, h, qb);
    }
  }
}

__device__ __forceinline__ void misc_init(PP p) {
  float2* rope = (float2*)(p->ws + WS_ROPE);
  for (int idx = blockIdx.x * NTHR + otid(); idx < 8208 * 16; idx += gridDim.x * NTHR) {
    const int pos = idx >> 4, i = idx & 15;
    const float inv = 1.0f / powf(10000.f, (float)(2 * i) / 32.f);
    const float ang = (float)pos * inv;
    float s, c; sincosf(ang, &s, &c);
    rope[idx] = make_float2(c, s);
  }
  unsigned* z = (unsigned*)(p->ws + WS_KM);
  const int nz = (int)((WS_HM - WS_KM) / 4);
  for (int idx = blockIdx.x * NTHR + otid(); idx < nz; idx += gridDim.x * NTHR) z[idx] = 0u;
  unsigned* zs = (unsigned*)(p->ws + WS_SS) + SSLD;
  for (int idx = blockIdx.x * NTHR + otid(); idx < (NSLOT - 1) * SSLD; idx += gridDim.x * NTHR) zs[idx] = 0u;
}

#define XB_TMO      128
#define XB_XCNT(j)  (256  + 64 * (j))
#define XB_XSUB(j)  (1280 + 64 * (j))
#define XB_XGEN(j)  (2304 + 64 * (j))
#define XB_TOP      3328
#define XB_TOPGEN   3392
#define XCD_BAR_WORDS 3456
#define XB_SPIN_CAP (1u << 20)
DI unsigned xb_ld(unsigned* p)              { return __hip_atomic_load(p, __ATOMIC_RELAXED, __HIP_MEMORY_SCOPE_AGENT); }
DI unsigned xb_add(unsigned* p, unsigned v) { return __hip_atomic_fetch_add(p, v, __ATOMIC_RELAXED, __HIP_MEMORY_SCOPE_AGENT); }
DI unsigned xb_xcc_id() { return (unsigned)__builtin_amdgcn_s_getreg((3 << 11) | 20) & 0xFu; }
#define XB_SPIN(cond, bar) do { unsigned _sp = 0; while (cond) { __builtin_amdgcn_s_sleep(1); \
    if ((++_sp & 255u) == 0u) { if (xb_ld(&(bar)[XB_TMO])) break; if (_sp > XB_SPIN_CAP) { atomicAdd(&(bar)[XB_TMO], 1u); break; } } } } while (0)
struct XcdBarrier { unsigned* bar; unsigned x; volatile LAS unsigned* st; };
DI XcdBarrier xcd_barrier_post(unsigned* bar, volatile LAS unsigned* st) {
  XcdBarrier b; b.bar = bar; b.x = xb_xcc_id(); b.st = st;
  if (threadIdx.x == 0) (void)xb_add(&bar[XB_XCNT(b.x)], 1u);
  return b;
}
DI void xcd_barrier_complete(unsigned* bar, unsigned x, unsigned& nloc, unsigned& nx) {
  const unsigned G = gridDim.x * gridDim.y * gridDim.z;
  unsigned sum, cnt, mine, sp = 0u;
  for (;;) {
    sum = 0u; cnt = 0u; mine = 0u;
#pragma unroll
    for (unsigned j = 0; j < 16; ++j) { const unsigned c = xb_ld(&bar[XB_XCNT(j)]); sum += c; cnt += (c > 0u) ? 1u : 0u; mine = (j == x) ? c : mine; }
    if (sum == G) break;
    __builtin_amdgcn_s_sleep(1);
    if ((++sp & 255u) == 0u) { if (xb_ld(&bar[XB_TMO])) break; if (sp > XB_SPIN_CAP) { atomicAdd(&bar[XB_TMO], 1u); break; } }
  }
  nloc = mine > 0u ? mine : 1u; nx = cnt > 0u ? cnt : 1u;
}
DI void xcd_barrier(const XcdBarrier& b) {
  asm volatile("s_waitcnt vmcnt(0)" ::: "memory");
  __syncthreads();
  if (threadIdx.x == 0) {
    unsigned* bar = b.bar;
    __builtin_amdgcn_s_waitcnt(0);
    unsigned nloc = b.st[0], nx = b.st[1];
    if (nloc == 0u) { xcd_barrier_complete(bar, b.x, nloc, nx); b.st[0] = nloc; b.st[1] = nx; }
    const unsigned old = xb_add(&bar[XB_XSUB(b.x)], 1u);
    const unsigned gen = old / nloc;
    if (old + 1u == (gen + 1u) * nloc) {
      __builtin_amdgcn_fence(__ATOMIC_RELEASE, "agent");
      asm volatile("s_waitcnt vmcnt(0)" ::: "memory");
      const unsigned og = xb_add(&bar[XB_TOP], 1u);
      const unsigned tg = og / nx;
      if (og + 1u == (tg + 1u) * nx) xb_add(&bar[XB_TOPGEN], 1u);
      else XB_SPIN(xb_ld(&bar[XB_TOPGEN]) == tg, bar);
      __builtin_amdgcn_fence(__ATOMIC_ACQUIRE, "agent");
      xb_add(&bar[XB_XGEN(b.x)], 1u);
      asm volatile("s_waitcnt vmcnt(0)" ::: "memory");
    } else {
      XB_SPIN(xb_ld(&bar[XB_XGEN(b.x)]) == gen, bar);
      __builtin_amdgcn_fence(__ATOMIC_ACQUIRE, "agent");
      asm volatile("s_waitcnt vmcnt(0)" ::: "memory");
    }
  }
  __syncthreads();
}

#define GSYNC() do { xcd_barrier(xb); p = launder(p); } while (0)
__device__ __forceinline__ void ffn(PP p, int f, int sin, int sout, const XcdBarrier& xb, bool with_kv) {
  if (with_kv) {
    unsigned char* ws = p->ws; float* SS = (float*)(ws + WS_SS);
    EpiDKV E{(u16*)(ws + WS_CKV), SS + (size_t)sin * SSLD, SS + (size_t)SLOT_KV * SSLD, (const float*)(ws + WS_ROPE), (u16*)p->out, (u16*)(ws + WS_KM)};
    gemm_all<EpiDKV>(Gemm{(const u16*)(ws + WS_XN), (const u16*)(ws + WS_WDKV), 1024, 1024, 1024, 2, 0, 128}, 9, E);
  }
  {
    unsigned char* ws = p->ws;
    EpiSwiglu E{(u16*)(ws + WS_G), (const float*)(ws + WS_SS) + (size_t)sin * SSLD};
    gemm_all<EpiSwiglu>(Gemm{(const u16*)(ws + WS_XN), (const u16*)(ws + WS_WGU + (size_t)f * WGU_ONE), 1024, 1024, 1024, 22, 0, 0}, DFF / 16, E, ogdim() == 256 ? 128 : 0);
    if (f < 7) { const int gd = ogdim(), bid = obid();
      if (gd == 256) { if (bid >= 128) { if (f == 0) conv_ffn(p, 0, bid - 128, 128, 352, 528); conv_ffn(p, f + 1, bid - 128, 128); } }
      else { if (f == 0) conv_ffn(p, 0, bid, gd, 352, 528); conv_ffn(p, f + 1, bid, gd); } }
    if (DUP_GU) { xcd_barrier(xb); gemm_phase<EpiSwiglu>(Gemm{(const u16*)(ws + WS_XN), (const u16*)(ws + WS_WGU + (size_t)f * WGU_ONE), 1024, 1024, 1024, 22, 0, 0}, E); }
    if (DUP_SKINNY) { xcd_barrier(xb); skinny<EpiSwiglu>(Gemm{(const u16*)(ws + WS_XN), (const u16*)(ws + WS_WGU + (size_t)f * WGU_ONE), 1024, 1024, 1024, 22, 0, 0}, DFF / 16, E); }
  }
  GSYNC();
  {
    unsigned char* ws = p->ws;
    EpiResidT<false> E{(u16*)(ws + WS_XN), (u16*)(ws + WS_LO), (float*)(ws + WS_SS) + (size_t)sout * SSLD, nullptr, 0.5f};
    gemm_all<EpiResidT<false>>(Gemm{(const u16*)(ws + WS_G), (const u16*)(ws + WS_WD + (size_t)f * WD_ONE), DFF, DFF, DFF, 4, 0, 0}, 1024 / 32, E);
  }
  if (with_kv) {
    unsigned char* ws = p->ws; float* SS = (float*)(ws + WS_SS);
    EpiKV E{(u16*)p->out, (u16*)p->out + KF_ELEMS, (u16*)(ws + WS_KM), (u16*)(ws + WS_VM), SS + (size_t)SLOT_KV * SSLD};
    gemm_all<EpiKV>(Gemm{(const u16*)(ws + WS_CKV), (const u16*)(ws + WS_WUKV), 256, 256, 256, 4, 0, 0}, 32, E);
  }
  GSYNC();
}

__global__ void __launch_bounds__(NTHR, 2) mega(Params p_unused) {
  extern __shared__ __attribute__((aligned(16))) unsigned char shm_top[];
  cg::grid_group grid = cg::this_grid();
  PP p = launder((PP)__builtin_amdgcn_kernarg_segment_ptr());

  {
    unsigned* bw = (unsigned*)(p->ws + WS_BAR);
    for (int idx = blockIdx.x * NTHR + otid(); idx < XCD_BAR_WORDS; idx += gridDim.x * NTHR) bw[idx] = 0u;
    if (threadIdx.x < 4) ((volatile LAS unsigned*)((LAS unsigned char*)shm_top + SHM_B))[threadIdx.x] = 0u;
  }
  conv_ffn(p, 0, blockIdx.x, gridDim.x, 0, 352);
  conv_small(p);
  misc_init(p);
  norm_rows<1>(p, nullptr);
  grid.sync();
  p = launder(p);
  const XcdBarrier xb = xcd_barrier_post((unsigned*)(p->ws + WS_BAR), (volatile LAS unsigned*)((LAS unsigned char*)shm_top + SHM_B));

  for (int l = 0; l < DEPTH; ++l) {
    ffn(p, l * 2, 3 * l, 3 * l + 1, xb, l == 2);
    unsigned char* ws = p->ws;
    float* SS = (float*)(ws + WS_SS);
    u16* HB = (u16*)(ws + WS_XN);
    float* Hm = (float*)(ws + WS_HM);
    if (l < 2) {
      u16* P = (u16*)(ws + WS_G + GA_P);
      pool_phase(HB, SS + (size_t)(3 * l + 1) * SSLD, p->in[6] + l * DM, P);
      GSYNC();
      ws = p->ws; SS = (float*)(ws + WS_SS); HB = (u16*)(ws + WS_XN); Hm = (float*)(ws + WS_HM); P = (u16*)(ws + WS_G + GA_P);
      {
        EpiResidT<true> E{HB, (u16*)(ws + WS_LO), SS + (size_t)(3 * l + 2) * SSLD, p->in[12] + l * DM, 1.f};
        gemm_all<EpiResidT<true>>(Gemm{P, (const u16*)(ws + WS_WPOOL) + (size_t)l * 4 * 65536, 1024, 256, 256, 4, 256, 0}, 32, E);
      }
      GSYNC();
    } else {
      const int j = l - 2;
      {
        EpiDQ E{(u16*)(ws + WS_G + GA_CQN), SS + (size_t)(3 * l + 1) * SSLD, SS + (size_t)(SLOT_Q + j) * SSLD};
        gemm_all<EpiDQ>(Gemm{HB, (const u16*)(ws + WS_WDQ) + (size_t)j * 512 * 1024, 1024, 1024, 1024, 2, 0, 0}, 12, E);
      }
      GSYNC();
      ws = p->ws; SS = (float*)(ws + WS_SS);
      {
        EpiQ E{(u16*)(ws + WS_G + GA_Q), (const float*)(ws + WS_ROPE), SS + (size_t)(SLOT_Q + j) * SSLD, 0.10206207261596577f * 1.4426950408889634f};
        gemm_all<EpiQ>(Gemm{(const u16*)(ws + WS_G + GA_CQN), (const u16*)(ws + WS_WUQ) + (size_t)j * 768 * 384, 384, 384, 384, 3, 0, 0}, 24, E);
      }
      GSYNC();
      attn_phase(p);
      if (DUP_ATTN) { GSYNC(); attn_phase(p); }
      GSYNC();
      ws = p->ws; SS = (float*)(ws + WS_SS); HB = (u16*)(ws + WS_XN); Hm = (float*)(ws + WS_HM);
      {
        EpiResidT<false> E{HB, (u16*)(ws + WS_LO), SS + (size_t)(3 * l + 2) * SSLD, nullptr, 1.f};
        gemm_all<EpiResidT<false>>(Gemm{(const u16*)(ws + WS_G + GA_O), (const u16*)(ws + WS_WO) + (size_t)j * 1024 * 512, 512, 512, 512, 4, 0, 0}, 32, E);
      }
      GSYNC();
    }
    ffn(p, l * 2 + 1, 3 * l + 2, 3 * l + 3, xb, false);
  }
  norm_rows<2>(p, p->in[22]);
}

extern "C" void kernel_launch(void* const* d_in, const int* in_sizes, int n_in, void* d_out, int out_size,
                              void* d_ws, size_t ws_size, hipStream_t stream) {
  static int grid_blocks = 0;
  if (grid_blocks == 0) {
    if (n_in != 23 || out_size != MR * DM || ws_size < WS_END) {
      fprintf(stderr, "kernel_launch: unexpected problem (n_in %d out %d ws %zu need %zu)\n", n_in, out_size, ws_size, (size_t)WS_END);
      grid_blocks = -1; return;
    }
    int dev = 0, cus = 0, per_cu = 0;
    hipGetDevice(&dev);
    hipDeviceGetAttribute(&cus, hipDeviceAttributeMultiprocessorCount, dev);
    hipFuncSetAttribute((const void*)mega, hipFuncAttributeMaxDynamicSharedMemorySize, SHM_B + 16);
    hipOccupancyMaxActiveBlocksPerMultiprocessor(&per_cu, (const void*)mega, NTHR, SHM_B + 16);
    if (per_cu < 1) { fprintf(stderr, "kernel_launch: occupancy query says %d blocks/CU\n", per_cu); per_cu = 1; }
    grid_blocks = cus * 1;
    (void)hipGetLastError();
  }
  if (grid_blocks < 0) return;
  Params hp{};
  for (int i = 0; i < 23; ++i) hp.in[i] = (const float*)d_in[i];
  hp.out = (float*)d_out; hp.ws = (unsigned char*)d_ws;
  void* args[] = {&hp};
  hipError_t e = hipLaunchCooperativeKernel((const void*)mega, dim3(grid_blocks), dim3(NTHR), args, SHM_B + 16, stream);
  if (e != hipSuccess) fprintf(stderr, "cooperative launch failed: %s (grid %d)\n", hipGetErrorString(e), grid_blocks);
}
```

```cpp
#include <hip/hip_runtime.h>
#include <hip/hip_bf16.h>
#include <hip/hip_cooperative_groups.h>
#include <cstdio>
namespace cg = cooperative_groups;

typedef unsigned short u16;
using bf16x8 = __attribute__((ext_vector_type(8))) short;
using f32x4 = __attribute__((ext_vector_type(4))) float;
using f32x16 = __attribute__((ext_vector_type(16))) float;
#define DI __device__ __forceinline__

constexpr int DM = 1024, SEQ = 8192, MR = 16384, NMETA = 16, MALL = MR + NMETA, MPAD = 16640;
constexpr int DFF = 2816, DEPTH = 4;
constexpr int NTHR = 512;
#define DUP_CONV 0
#define DUP_ATTN 0
#define DUP_GU 0
#define DUP_SKINNY 0
constexpr float EPS = 1e-6f;

constexpr size_t al256(size_t x) { return (x + 255) & ~(size_t)255; }
constexpr size_t WS_XN = 0;
constexpr size_t WS_G = WS_XN + al256((size_t)MPAD * 1024 * 2);
constexpr size_t G_BYTES = (size_t)MPAD * DFF * 2;
constexpr size_t WS_WGU = WS_G + al256(G_BYTES);
constexpr size_t WGU_ONE = (size_t)2 * DFF * 1024 * 2;
constexpr size_t WS_WD = WS_WGU + 8 * WGU_ONE;
constexpr size_t WD_ONE = (size_t)1024 * DFF * 2;
constexpr size_t WS_WPOOL = WS_WD + 8 * WD_ONE;
constexpr size_t WS_WDKV = WS_WPOOL + (size_t)8 * 65536 * 2;
constexpr size_t WS_WUKV = WS_WDKV + (size_t)512 * 1024 * 2;
constexpr size_t WS_WDQ = WS_WUKV + (size_t)1024 * 256 * 2;
constexpr size_t WS_WUQ = WS_WDQ + (size_t)2 * 512 * 1024 * 2;
constexpr size_t WS_WO = WS_WUQ + (size_t)2 * 768 * 384 * 2;
constexpr size_t WS_KF = WS_WO + (size_t)2 * 1024 * 512 * 2;
constexpr size_t WS_LO = WS_KF;
constexpr size_t WS_VT = WS_KF + (size_t)2 * 8 * 8192 * 96 * 2;
constexpr size_t WS_KM = WS_VT + (size_t)2 * 8 * 64 * 8192 * 2;
constexpr size_t WS_VM = WS_KM + (size_t)8 * 64 * 96 * 2;
constexpr size_t WS_HM = WS_VM + (size_t)8 * 64 * 64 * 2;
constexpr size_t WS_ROPE = WS_HM + (size_t)16 * 1024 * 4;
constexpr size_t WS_SS = WS_ROPE + al256((size_t)8208 * 16 * 8);
constexpr int NSLOT = 16, SSLD = 16512, SLOT_Q = 13, SLOT_KV = 15;
constexpr size_t WS_CKV = WS_SS + (size_t)NSLOT * SSLD * 4;
constexpr size_t WS_BAR = WS_CKV + al256((size_t)MPAD * 256 * 2);
constexpr size_t WS_END = WS_BAR + 16384;
constexpr size_t GA_P = 0;
constexpr size_t GA_CQ = 0;
constexpr size_t GA_CQN = al256((size_t)MPAD * 384 * 4);
constexpr size_t GA_Q = GA_CQN + al256((size_t)MPAD * 384 * 2);
constexpr size_t GA_O = GA_Q + al256((size_t)MPAD * 768 * 2);
static_assert(GA_O + (size_t)MPAD * 512 * 2 <= G_BYTES, "alias overflow");
static_assert((size_t)MPAD * 1024 * 2 <= (size_t)2 * 8 * 8192 * 96 * 2 + (size_t)2 * 8 * 64 * 8192 * 2, "LO must fit the old K/V region");
constexpr size_t KF_ELEMS = (size_t)2 * 8 * 8192 * 96;
static_assert((KF_ELEMS + (size_t)2 * 8 * 64 * 8192) * 2 <= (size_t)MR * DM * 4, "K/V must fit d_out");

struct Params { const float* in[23]; float* out; unsigned char* ws; };
typedef const __attribute__((address_space(4))) Params* PP;
__device__ __forceinline__ PP launder(PP q) {
  unsigned long long v = (unsigned long long)q;
  unsigned lo = __builtin_amdgcn_readfirstlane((unsigned)v), hi = __builtin_amdgcn_readfirstlane((unsigned)(v >> 32));
  asm volatile("" : "+s"(lo), "+s"(hi));
  return (PP)(((unsigned long long)hi << 32) | lo);
}

__device__ __forceinline__ int ogdim() { int g = __builtin_amdgcn_readfirstlane(gridDim.x); asm volatile("" : "+s"(g)); return g; }
__device__ __forceinline__ int obid() { int b = __builtin_amdgcn_readfirstlane(blockIdx.x); asm volatile("" : "+s"(b)); return b; }
__device__ __forceinline__ int otid() { int t = threadIdx.x; asm volatile("" : "+v"(t)); return t; }
DI u16 f2bf(float x) { return __builtin_bit_cast(u16, (__bf16)x); }
DI float bf2f(u16 v) { return __uint_as_float(((unsigned)v) << 16); }
DI float xhalf_max(float v) {
  const unsigned u = __float_as_uint(v);
  const auto r = __builtin_amdgcn_permlane32_swap(u, u, false, false);
  return fmaxf(__uint_as_float(r[0]), __uint_as_float(r[1]));
}
DI float xhalf_sum(float v) {
  const unsigned u = __float_as_uint(v);
  const auto r = __builtin_amdgcn_permlane32_swap(u, u, false, false);
  return __uint_as_float(r[0]) + __uint_as_float(r[1]);
}
DI float wave_sum(float v) {
  for (int o = 32; o > 0; o >>= 1) v += __shfl_xor(v, o);
  return v;
}
DI float silu_mul(float g, float u) { return g * __builtin_amdgcn_rcpf(1.f + __expf(-g)) * u; }
DI int row_pos(int row) { return row < MR ? (row & (SEQ - 1)) + NMETA : row - MR; }
DI int permt(int t) { return (t & ~12) | ((t & 4) << 1) | ((t & 8) >> 1); }

DI f32x4 hl_sum(unsigned h01, unsigned h23, unsigned l01, unsigned l23) {
  f32x4 r;
  r[0] = __uint_as_float(h01 << 16) + __uint_as_float(l01 << 16);
  r[1] = __uint_as_float(h01 & 0xffff0000u) + __uint_as_float(l01 & 0xffff0000u);
  r[2] = __uint_as_float(h23 << 16) + __uint_as_float(l23 << 16);
  r[3] = __uint_as_float(h23 & 0xffff0000u) + __uint_as_float(l23 & 0xffff0000u);
  return r;
}
DI void hl_split(f32x4 h, ushort4& hi, ushort4& lo) {
  hi = (ushort4){f2bf(h[0]), f2bf(h[1]), f2bf(h[2]), f2bf(h[3])};
  lo.x = f2bf(h[0] - bf2f(hi.x)); lo.y = f2bf(h[1] - bf2f(hi.y)); lo.z = f2bf(h[2] - bf2f(hi.z)); lo.w = f2bf(h[3] - bf2f(hi.w));
}
DI float* hrow_ptr(float* Hr, float* Hm, int row) { return row < MR ? Hr + (size_t)row * DM : Hm + (size_t)(row - MR) * DM; }
DI float rs_of(const float* ss, int row, float invn) { return rsqrtf(ss[row] * invn + EPS); }
DI ushort4 pk4(f32x4 v) { ushort4 o; o.x = f2bf(v[0]); o.y = f2bf(v[1]); o.z = f2bf(v[2]); o.w = f2bf(v[3]); return o; }
DI void row_ss_add(float* ss, int row, float part, bool valid) {
  part += __shfl_xor(part, 16); part += __shfl_xor(part, 32);
  if (valid && (__lane_id() < 16)) atomicAdd(ss + row, part);
}
DI f32x4 swiglu4(f32x4 g, f32x4 u, float r) {
  const float a = -1.4426950408889634f * r, b = r * r;
  const f32x4 t = g * a;
  f32x4 d;
  d[0] = __builtin_amdgcn_rcpf(1.f + __builtin_amdgcn_exp2f(t[0])); d[1] = __builtin_amdgcn_rcpf(1.f + __builtin_amdgcn_exp2f(t[1]));
  d[2] = __builtin_amdgcn_rcpf(1.f + __builtin_amdgcn_exp2f(t[2])); d[3] = __builtin_amdgcn_rcpf(1.f + __builtin_amdgcn_exp2f(t[3]));
  return (g * u) * (d * b);
}
struct EpiSwiglu {
  static constexpr bool GU = true, PERM = true;
  u16* G; const float* ssin;
  DI void colpre(int, f32x4&, f32x4&) const {}
  DI void pre(int row, int, float& r, f32x4&, f32x4&) const { r = ssin[row]; }
  DI void op(int row, int col, f32x4 g, f32x4 u, float r) const {
    r = rsqrtf(r * (1.f / DM) + EPS);
    *(ushort4*)(G + (size_t)row * DFF + col) = pk4(swiglu4(g, u, r));
  }
  DI void op8(int row, int col, f32x4 g0, f32x4 u0, f32x4 g1, f32x4 u1, float r) const {
    r = rsqrtf(r * (1.f / DM) + EPS);
    const ushort4 a = pk4(swiglu4(g0, u0, r)), b = pk4(swiglu4(g1, u1, r));
    bf16x8 o = {(short)a.x, (short)a.y, (short)a.z, (short)a.w, (short)b.x, (short)b.y, (short)b.z, (short)b.w};
    *(bf16x8*)(G + (size_t)row * DFF + col) = o;
  }
};
struct EpiNull {
  static constexpr bool GU = true, PERM = true;
  u16* G;
  DI void colpre(int, f32x4&, f32x4&) const {}
  DI void pre(int, int, float&, f32x4&, f32x4&) const {}
  DI void op(int row, int col, f32x4 g, f32x4 u, float) const { if (g[0] + u[1] + g[2] + u[3] == 12345.678f) G[(size_t)row * DFF + col] = 1; }
  DI void op8(int row, int col, f32x4 g, f32x4 u, f32x4, f32x4, float) const { if (g[0] + u[1] + g[2] + u[3] == 12345.678f) G[(size_t)row * DFF + col] = 1; }
};
template <bool HAS_CS>
struct EpiResidT {
  static constexpr bool GU = false, PERM = true;
  static constexpr int BATCH_ROWS = HAS_CS ? 2 : 4;
  u16* HI; u16* LO; float* ssout; const float* cs; float scale;
  template <int D1> DI void colpre(int col, f32x4& c0, f32x4& c1) const {
    c0 = (f32x4){scale, scale, scale, scale}; c1 = c0;
    if (HAS_CS) { c0 *= *(const f32x4*)(cs + col); c1 *= *(const f32x4*)(cs + col + D1); }
  }
  template <int D1> DI void pre(int row, int col, float&, f32x4& x0, f32x4& x1) const {
    const size_t o = (size_t)row * DM + col;
    if (D1 == 4) { x0 = *(const f32x4*)(HI + o); x1 = *(const f32x4*)(LO + o); }
    else {
      const uint2 a = *(const uint2*)(HI + o), b = *(const uint2*)(LO + o), c = *(const uint2*)(HI + o + D1), d = *(const uint2*)(LO + o + D1);
      x0 = (f32x4){__uint_as_float(a.x), __uint_as_float(a.y), __uint_as_float(b.x), __uint_as_float(b.y)};
      x1 = (f32x4){__uint_as_float(c.x), __uint_as_float(c.y), __uint_as_float(d.x), __uint_as_float(d.y)};
    }
  }
  template <int D1> DI void op(int row, int col, f32x4 v0, f32x4 v1, float, f32x4 x0, f32x4 x1, f32x4 c0, f32x4 c1) const {
    const size_t o = (size_t)row * DM + col;
    f32x4 h0, h1;
    if (D1 == 4) {
      h0 = hl_sum(__float_as_uint(x0[0]), __float_as_uint(x0[1]), __float_as_uint(x1[0]), __float_as_uint(x1[1])) + c0 * v0;
      h1 = hl_sum(__float_as_uint(x0[2]), __float_as_uint(x0[3]), __float_as_uint(x1[2]), __float_as_uint(x1[3])) + c1 * v1;
    } else {
      h0 = hl_sum(__float_as_uint(x0[0]), __float_as_uint(x0[1]), __float_as_uint(x0[2]), __float_as_uint(x0[3])) + c0 * v0;
      h1 = hl_sum(__float_as_uint(x1[0]), __float_as_uint(x1[1]), __float_as_uint(x1[2]), __float_as_uint(x1[3])) + c1 * v1;
    }
    ushort4 ha, la, hb, lb;
    hl_split(h0, ha, la); hl_split(h1, hb, lb);
    if (D1 == 4) {
      const bf16x8 hv = {(short)ha.x, (short)ha.y, (short)ha.z, (short)ha.w, (short)hb.x, (short)hb.y, (short)hb.z, (short)hb.w};
      const bf16x8 lv = {(short)la.x, (short)la.y, (short)la.z, (short)la.w, (short)lb.x, (short)lb.y, (short)lb.z, (short)lb.w};
      *(bf16x8*)(HI + o) = hv; *(bf16x8*)(LO + o) = lv;
    } else {
      *(ushort4*)(HI + o) = ha; *(ushort4*)(LO + o) = la; *(ushort4*)(HI + o + D1) = hb; *(ushort4*)(LO + o + D1) = lb;
    }
    const f32x4 q = h0 * h0 + h1 * h1;
    row_ss_add(ssout, row, q[0] + q[1] + q[2] + q[3], true);
  }
};
struct EpiDQ {
  static constexpr int BATCH_ROWS = 4;
  static constexpr bool GU = false, PERM = true;
  u16* CB; const float* ssin; float* ssout;
  template <int D1> DI void colpre(int, f32x4&, f32x4&) const {}
  template <int D1> DI void pre(int row, int, float& r, f32x4&, f32x4&) const { r = ssin[row]; }
  template <int D1> DI void op(int row, int col, f32x4 v0, f32x4 v1, float r, f32x4, f32x4, f32x4, f32x4) const {
    r = rsqrtf(r * (1.f / DM) + EPS);
    const bool ok = col < 384;
    v0 *= r; v1 *= r;
    if (ok) { *(ushort4*)(CB + (size_t)row * 384 + col) = pk4(v0); *(ushort4*)(CB + (size_t)row * 384 + col + D1) = pk4(v1); }
    const f32x4 q = v0 * v0 + v1 * v1;
    row_ss_add(ssout, row, ok ? q[0] + q[1] + q[2] + q[3] : 0.f, ok);
  }
};
struct EpiDKV {
  static constexpr int BATCH_ROWS = 4;
  static constexpr bool GU = false, PERM = false;
  u16* CB; const float* ssin; float* ssout; const float* rope; u16* Kf; u16* Km;
  template <int D1> DI void colpre(int, f32x4&, f32x4&) const {}
  template <int D1> DI void pre(int row, int col, float& r, f32x4& x0, f32x4& x1) const {
    r = ssin[row];
    if ((col & ~31) == 256) { const float* rp = rope + (size_t)(row_pos(row) * 16 + (col & 15)) * 2; x0 = *(const f32x4*)rp; x1 = *(const f32x4*)(rp + 4); }
  }
  template <int D1> DI void op(int row, int col, f32x4 v0, f32x4 v1, float r, f32x4 ra, f32x4 rb, f32x4, f32x4) const {
    static_assert(D1 == 16, "rotary pairs are 16 columns apart");
    r = rsqrtf(r * (1.f / DM) + EPS);
    v0 *= r; v1 *= r;
    const bool ok = col < 256;
    if (ok) { *(ushort4*)(CB + (size_t)row * 256 + col) = pk4(v0); *(ushort4*)(CB + (size_t)row * 256 + col + 16) = pk4(v1); }
    const f32x4 q = v0 * v0 + v1 * v1;
    row_ss_add(ssout, row, ok ? q[0] + q[1] + q[2] + q[3] : 0.f, ok);
    if ((col & ~31) == 256) {
      const f32x4 c = {ra[0], ra[2], rb[0], rb[2]}, s = {ra[1], ra[3], rb[1], rb[3]};
      const ushort4 o1 = pk4(v0 * c - v1 * s), o2 = pk4(v1 * c + v0 * s);
      const int i0 = col & 15;
      for (int h = 0; h < 8; ++h) {
        u16* kd = row < MR ? Kf + ((size_t)((row >> 13) * 8 + h) * SEQ + (row & (SEQ - 1))) * 96
                           : Km + (h * 64 + (row - MR)) * 96;
        *(ushort4*)(kd + 64 + i0) = o1; *(ushort4*)(kd + 80 + i0) = o2;
      }
    }
  }
};
struct EpiQ {
  static constexpr int BATCH_ROWS = 4;
  static constexpr bool GU = false, PERM = false;
  u16* Q; const float* rope; const float* ssin; float qs;
  template <int D1> DI void colpre(int, f32x4&, f32x4&) const {}
  template <int D1> DI void pre(int row, int col, float& r, f32x4& x0, f32x4& x1) const {
    r = ssin[row];
    if (((col & ~31) % 96) == 64) { const float* rp = rope + (size_t)(row_pos(row) * 16 + (col & 15)) * 2; x0 = *(const f32x4*)rp; x1 = *(const f32x4*)(rp + 4); }
  }
  template <int D1> DI void op(int row, int col, f32x4 v0, f32x4 v1, float r, f32x4 ra, f32x4 rb, f32x4, f32x4) const {
    static_assert(D1 == 16, "rotary pairs are 16 columns apart");
    r = rsqrtf(r * (1.f / 384.f) + EPS) * qs;
    v0 *= r; v1 *= r;
    if (((col & ~31) % 96) == 64) {
      const f32x4 c = {ra[0], ra[2], rb[0], rb[2]}, s = {ra[1], ra[3], rb[1], rb[3]};
      const f32x4 o1 = v0 * c - v1 * s, o2 = v1 * c + v0 * s;
      v0 = o1; v1 = o2;
    }
    *(ushort4*)(Q + (size_t)row * 768 + col) = pk4(v0);
    *(ushort4*)(Q + (size_t)row * 768 + col + 16) = pk4(v1);
  }
};
struct EpiKV {
  static constexpr int BATCH_ROWS = 4;
  static constexpr bool GU = false, PERM = true;
  u16 *Kf, *Vt, *Km, *Vm; const float* ssin;
  template <int D1> DI void colpre(int, f32x4&, f32x4&) const {}
  template <int D1> DI void pre(int row, int, float& r, f32x4&, f32x4&) const { r = ssin[row]; }
  DI void one(int row, int col, f32x4 v) const {
    if (col < 512) {
      const int h = col >> 6, d = col & 63;
      u16* kd = row < MR ? Kf + ((size_t)((row >> 13) * 8 + h) * SEQ + (row & (SEQ - 1))) * 96 + d
                         : Km + (h * 64 + (row - MR)) * 96 + d;
      *(ushort4*)kd = pk4(v);
    } else {
      const int c = col - 512, h = c >> 6, dv = c & 63;
      u16* vd = row < MR ? Vt + ((size_t)((row >> 13) * 8 + h) * 64 + dv) * SEQ + permt(row & (SEQ - 1))
                         : Vm + (h * 64 + dv) * 64 + permt(row - MR);
      const int st = row < MR ? SEQ : 64;
      vd[0] = f2bf(v[0]); vd[st] = f2bf(v[1]); vd[2 * st] = f2bf(v[2]); vd[3 * st] = f2bf(v[3]);
    }
  }
  template <int D1> DI void op(int row, int col, f32x4 v0, f32x4 v1, float r, f32x4, f32x4, f32x4, f32x4) const {
    r = rsqrtf(r * (1.f / 256.f) + EPS);
    one(row, col, v0 * r); one(row, col + D1, v1 * r);
  }
};

#define LAS __attribute__((address_space(3)))
constexpr int BM = 256, BK = 64, HALF = 128, HTB = HALF * BK * 2, SHM_B = 8 * HTB;
DI int lds_byte(int r, int c) {
  const int st = (r >> 4) * 2 + (c >> 5), rr = r & 15, cc = c & 31, ob = rr * 64 + cc * 2;
  return st * 1024 + (ob ^ (((ob >> 9) & 1) << 5));
}
DI int perm32(int rho) { const int n = rho >> 4, i = rho & 15; return 8 * (i >> 2) + 4 * n + (i & 3); }
DI void stage_rc(int b, int& R, int& C) {
  const int st = b / 1024, sb = b % 1024, swz = sb ^ (((sb >> 9) & 1) << 5);
  R = (st >> 1) * 16 + swz / 64; C = (st & 1) * 32 + (swz % 64) / 2;
}
struct Gemm { const u16* A; const u16* Bt; int lda, ldb, K, nN, a_pn_el, boff; };
DI bool unit_next(int i, int nN, int boff, int& pm, int& pn) {
  const int nM = MR / BM, nwg = nM * nN, G = gridDim.x;
  const long L = (long)i * G + (int)(((unsigned)obid() + (unsigned)boff) % (unsigned)G); if (L >= nwg) return false;
  int wgid = (int)L; { const int q = nwg / 8, r = nwg % 8, xcd = wgid % 8, off = wgid / 8; wgid = (xcd < r ? xcd * (q + 1) : r * (q + 1) + (xcd - r) * q) + off; }
  const int WGM = nN >= 8 ? 4 : 8;
  const int nig = WGM * nN, gid = wgid / nig, fm = gid * WGM, gsz = (nM - fm) < WGM ? (nM - fm) : WGM;
  pm = fm + ((wgid % nig) % gsz); pn = (wgid % nig) / gsz; return true;
}

template <class Epi>
__device__ __forceinline__ void gemm_phase(const Gemm g, const Epi& E) {
  extern __shared__ __attribute__((aligned(16))) unsigned char shm_raw[];
  LAS unsigned char* lds = (LAS unsigned char*)shm_raw;
  const int tid = otid(), wid = __builtin_amdgcn_readfirstlane(tid >> 6), lane = tid & 63, wr = wid >> 2, wc = wid & 3, fr = lane & 15, fq = lane >> 4;
  const int K = g.K, nt = K / BK;
  unsigned voffA[2], voffB[2];
#pragma unroll
  for (int i = 0; i < 2; ++i) { int R, C; stage_rc(tid * 16 + i * 8192, R, C);
    const int Rb = Epi::PERM ? ((R & ~31) + perm32(R & 31)) : R;
    voffA[i] = (unsigned)(R * g.lda + C) * 2u; voffB[i] = (unsigned)(Rb * g.ldb + C) * 2u; }
  const size_t kstep = (size_t)(BK * 2);
  const size_t hstepA = (size_t)HALF * g.lda * 2, hstepB = (size_t)HALF * g.ldb * 2;
  const unsigned ldsw = (unsigned)wid * 1024u;
  const int aoff = lds_byte(wr * 64 + fr, fq * 8), boff = lds_byte(wc * 32 + fr, fq * 8);
#define PG8_SA(b, h) (((b) * 2 + (h)) * HTB)
#define PG8_SB(b, h) ((4 + (b) * 2 + (h)) * HTB)
#define PG8_STAGE(bufoff, gbase, voff) do { _Pragma("unroll") for (int _i = 0; _i < 2; ++_i) \
    __builtin_amdgcn_global_load_lds((const unsigned*)((const char*)(gbase) + (voff)[_i]), (LAS unsigned*)(lds + (bufoff) + ldsw + _i * 8192), 16, 0, 0); } while (0)
#define PG8_LDA(dst, b, h) do { _Pragma("unroll") for (int m = 0; m < 4; ++m) _Pragma("unroll") for (int k = 0; k < 2; ++k) dst[m][k] = *(const LAS bf16x8*)(lds + PG8_SA(b, h) + aoff + m * 2048 + k * 1024); } while (0)
#define PG8_LDB(dst, b, h) do { _Pragma("unroll") for (int n = 0; n < 2; ++n) _Pragma("unroll") for (int k = 0; k < 2; ++k) dst[n][k] = *(const LAS bf16x8*)(lds + PG8_SB(b, h) + boff + n * 2048 + k * 1024); } while (0)
#define PG8_MMA(ai, bj, At_, Bt_) do { __builtin_amdgcn_s_setprio(1); _Pragma("unroll") for (int m = 0; m < 4; ++m) _Pragma("unroll") for (int n = 0; n < 2; ++n) _Pragma("unroll") for (int k = 0; k < 2; ++k) \
    acc[ai][bj][m][n] = __builtin_amdgcn_mfma_f32_16x16x32_bf16(Bt_[n][k], At_[m][k], acc[ai][bj][m][n], 0, 0, 0); __builtin_amdgcn_s_setprio(0); } while (0)
#define PG8_WAIT_V(n) asm volatile("s_waitcnt vmcnt(" #n ")" ::: "memory")
#define PG8_WAIT_L(n) asm volatile("s_waitcnt lgkmcnt(" #n ")" ::: "memory")
#define PG8_BAR __builtin_amdgcn_s_barrier()
#define PG8_SCHED __builtin_amdgcn_sched_barrier(0)
  int cpm, cpn, npm = 0, npn = 0, ui = 0;
  if (!unit_next(0, g.nN, g.boff, cpm, cpn)) return;
  f32x4 acc[2][2][4][2];
#pragma unroll
  for (int a = 0; a < 2; ++a)
#pragma unroll
    for (int b = 0; b < 2; ++b)
#pragma unroll
      for (int m = 0; m < 4; ++m)
#pragma unroll
        for (int n = 0; n < 2; ++n) acc[a][b][m][n] = (f32x4){0.f, 0.f, 0.f, 0.f};
  bf16x8 At[4][2], B0[2][2], B1[2][2];
  const char* cA = (const char*)(g.A + (size_t)cpn * g.a_pn_el) + (size_t)cpm * 2 * hstepA;
  const char* cB = (const char*)g.Bt + (size_t)cpn * 2 * hstepB;
  PG8_STAGE(PG8_SB(0, 0), cB, voffB); PG8_STAGE(PG8_SA(0, 0), cA, voffA); PG8_STAGE(PG8_SB(0, 1), cB + hstepB, voffB); PG8_STAGE(PG8_SA(0, 1), cA + hstepA, voffA);
  if (wr == 1) PG8_BAR;
  PG8_WAIT_V(4); PG8_BAR;
  PG8_STAGE(PG8_SB(1, 0), cB + kstep, voffB); PG8_STAGE(PG8_SA(1, 0), cA + kstep, voffA); PG8_STAGE(PG8_SB(1, 1), cB + hstepB + kstep, voffB);
  PG8_WAIT_V(6); PG8_BAR;
  for (;;) {
    const bool has_next = unit_next(ui + 1, g.nN, g.boff, npm, npn);
    const char* nA = has_next ? (const char*)(g.A + (size_t)npn * g.a_pn_el) + (size_t)npm * 2 * hstepA : cA;
    const char* nB = has_next ? (const char*)g.Bt + (size_t)npn * 2 * hstepB : cB;
#pragma unroll 1
    for (int t = 0; t < nt; t += 2) {
      const bool last = (t == nt - 2);
      const char* a1 = cA + (size_t)(t + 1) * kstep;
      const char* a2 = last ? nA : cA + (size_t)(t + 2) * kstep; const char* b2 = last ? nB : cB + (size_t)(t + 2) * kstep;
      const char* a3 = a2 + kstep; const char* b3 = b2 + kstep;
      PG8_LDB(B0, 0, 0); PG8_SCHED; PG8_LDA(At, 0, 0); PG8_STAGE(PG8_SA(1, 1), a1 + hstepA, voffA);
      PG8_WAIT_L(8); PG8_BAR; PG8_WAIT_L(0); PG8_MMA(0, 0, At, B0); PG8_BAR; PG8_SCHED;
      PG8_LDB(B1, 0, 1); PG8_STAGE(PG8_SB(0, 0), b2, voffB);
      PG8_BAR; PG8_WAIT_L(0); PG8_MMA(0, 1, At, B1); PG8_BAR;
      PG8_LDA(At, 0, 1); PG8_STAGE(PG8_SA(0, 0), a2, voffA);
      PG8_BAR; PG8_WAIT_L(0); PG8_MMA(1, 0, At, B0); PG8_BAR; PG8_SCHED;
      PG8_STAGE(PG8_SB(0, 1), b2 + hstepB, voffB);
      PG8_WAIT_V(6); PG8_BAR; PG8_MMA(1, 1, At, B1); PG8_BAR;
      PG8_LDB(B0, 1, 0); PG8_SCHED; PG8_LDA(At, 1, 0); PG8_STAGE(PG8_SA(0, 1), a2 + hstepA, voffA);
      PG8_WAIT_L(8); PG8_BAR; PG8_WAIT_L(0); PG8_MMA(0, 0, At, B0); PG8_BAR; PG8_SCHED;
      PG8_LDB(B1, 1, 1); PG8_STAGE(PG8_SB(1, 0), b3, voffB);
      PG8_BAR; PG8_WAIT_L(0); PG8_MMA(0, 1, At, B1); PG8_BAR;
      PG8_LDA(At, 1, 1); PG8_STAGE(PG8_SA(1, 0), a3, voffA);
      PG8_BAR; PG8_WAIT_L(0); PG8_MMA(1, 0, At, B0); PG8_BAR; PG8_SCHED;
      PG8_STAGE(PG8_SB(1, 1), b3 + hstepB, voffB);
      PG8_WAIT_V(6); PG8_BAR; PG8_MMA(1, 1, At, B1); PG8_BAR;
    }
    {
      const int t2 = otid(), wid2 = __builtin_amdgcn_readfirstlane(t2 >> 6), wr2 = wid2 >> 2, wc2 = wid2 & 3, fr2 = t2 & 15, fq2 = (t2 & 63) >> 4;
      const int row0 = cpm * BM + wr2 * 64 + fr2;
      const f32x4 z4 = {0.f, 0.f, 0.f, 0.f};
      constexpr int D1 = Epi::PERM ? 4 : 16, FQ = Epi::PERM ? 8 : 4;
      if constexpr (Epi::GU) {
        const int col0 = cpn * HALF + wc2 * 32 + FQ * fq2;
#pragma unroll
        for (int ai = 0; ai < 2; ++ai) {
          float rr[4]; f32x4 xa = z4, xb_ = z4;
#pragma unroll
          for (int m = 0; m < 4; ++m) { rr[m] = 0.f; E.pre(row0 + ai * HALF + m * 16, col0, rr[m], xa, xb_); }
#pragma unroll
          for (int m = 0; m < 4; ++m)
            E.op8(row0 + ai * HALF + m * 16, col0, acc[ai][0][m][0], acc[ai][1][m][0], acc[ai][0][m][1], acc[ai][1][m][1], rr[m]);
        }
      } else {
        const int col0 = cpn * BM + wc2 * 32 + FQ * fq2;
        f32x4 c0[2], c1[2];
#pragma unroll
        for (int bj = 0; bj < 2; ++bj) { c0[bj] = z4; c1[bj] = z4; E.template colpre<D1>(col0 + bj * HALF, c0[bj], c1[bj]); }
        constexpr int BR = Epi::BATCH_ROWS;
#pragma unroll
        for (int am = 0; am < 8 / BR; ++am) {
          const int r0b = am * BR;
          float rr[BR][2]; f32x4 x0[BR][2], x1[BR][2];
#pragma unroll
          for (int m = 0; m < BR; ++m)
#pragma unroll
            for (int bj = 0; bj < 2; ++bj) { const int rs = r0b + m; rr[m][bj] = 0.f; x0[m][bj] = z4; x1[m][bj] = z4;
              E.template pre<D1>(row0 + (rs >> 2) * HALF + (rs & 3) * 16, col0 + bj * HALF, rr[m][bj], x0[m][bj], x1[m][bj]); }
#pragma unroll
          for (int m = 0; m < BR; ++m)
#pragma unroll
            for (int bj = 0; bj < 2; ++bj) { const int rs = r0b + m;
              E.template op<D1>(row0 + (rs >> 2) * HALF + (rs & 3) * 16, col0 + bj * HALF, acc[rs >> 2][bj][rs & 3][0], acc[rs >> 2][bj][rs & 3][1], rr[m][bj], x0[m][bj], x1[m][bj], c0[bj], c1[bj]); }
        }
      }
    }
    if (!has_next) break;
#pragma unroll
    for (int a = 0; a < 2; ++a)
#pragma unroll
      for (int b = 0; b < 2; ++b)
#pragma unroll
        for (int m = 0; m < 4; ++m)
#pragma unroll
          for (int n = 0; n < 2; ++n) acc[a][b][m][n] = (f32x4){0.f, 0.f, 0.f, 0.f};
    cpm = npm; cpn = npn; cA = nA; cB = nB; ++ui;
  }
  PG8_WAIT_V(0);
  if (wr == 0) PG8_BAR;
  PG8_BAR;
#undef PG8_SA
#undef PG8_SB
#undef PG8_STAGE
#undef PG8_LDA
#undef PG8_LDB
#undef PG8_MMA
}

template <class Epi>
__device__ __forceinline__ void skinny(const Gemm g, int nitems, const Epi& E, int first_block = 0) {
  extern __shared__ __attribute__((aligned(16))) float sk_red[];
  const int tid = otid(), wave = __builtin_amdgcn_readfirstlane(tid >> 6), lane = tid & 63, G = gridDim.x;
  const int fr = lane & 15, fq = lane >> 4;
  const int nks = g.K >> 5;
  for (int it = (first_block ? (int)blockIdx.x - first_block + (blockIdx.x < (unsigned)first_block ? (1 << 28) : 0) : G - 1 - (int)blockIdx.x); it < nitems; it += (first_block ? G - first_block : G)) {
    int r0, r1, col, pn;
    if (Epi::GU) { pn = it >> 3; const int w = (it & 7) * 16; r0 = pn * 256 + w; r1 = r0 + 128; col = pn * 128 + w; }
    else { r0 = it * 32; r1 = r0 + 16; col = it * 32; pn = col >> 8; }
    const u16* ap = g.A + (size_t)pn * g.a_pn_el + (size_t)(MR + fr) * g.lda + fq * 8;
    const u16* b0p = g.Bt + (size_t)(r0 + fr) * g.ldb + fq * 8;
    const u16* b1p = g.Bt + (size_t)(r1 + fr) * g.ldb + fq * 8;
    f32x4 a0 = {0.f, 0.f, 0.f, 0.f}, a1 = {0.f, 0.f, 0.f, 0.f};
#pragma unroll 4
    for (int ks = wave; ks < nks; ks += 8) {
      const int k = ks * 32;
      const bf16x8 a = *(const bf16x8*)(ap + k);
      const bf16x8 b0 = *(const bf16x8*)(b0p + k);
      const bf16x8 b1 = *(const bf16x8*)(b1p + k);
      a0 = __builtin_amdgcn_mfma_f32_16x16x32_bf16(b0, a, a0, 0, 0, 0);
      a1 = __builtin_amdgcn_mfma_f32_16x16x32_bf16(b1, a, a1, 0, 0, 0);
    }
    __syncthreads();
    float* my = sk_red + (wave * 64 + lane) * 8;
    *(f32x4*)my = a0; *(f32x4*)(my + 4) = a1;
    __syncthreads();
    if (wave == 0) {
      f32x4 s0 = {0.f, 0.f, 0.f, 0.f}, s1 = {0.f, 0.f, 0.f, 0.f};
#pragma unroll
      for (int w = 0; w < 8; ++w) { s0 += *(const f32x4*)(sk_red + (w * 64 + lane) * 8); s1 += *(const f32x4*)(sk_red + (w * 64 + lane) * 8 + 4); }
      float r = 0.f; f32x4 x0 = {0.f, 0.f, 0.f, 0.f}, x1 = x0, c0 = x0, c1 = x0;
      if constexpr (Epi::GU) { E.pre(MR + fr, col + 4 * fq, r, x0, x1); E.op(MR + fr, col + 4 * fq, s0, s1, r); }
      else {
        E.template colpre<16>(col + 4 * fq, c0, c1);
        E.template pre<16>(MR + fr, col + 4 * fq, r, x0, x1);
        E.template op<16>(MR + fr, col + 4 * fq, s0, s1, r, x0, x1, c0, c1);
      }
    }
  }
  __syncthreads();
}
template <class Epi>
__device__ __forceinline__ void gemm_all(const Gemm g, int n_skinny, const Epi& E, int first_block = 0) {
  gemm_phase<Epi>(g, E);
  skinny<Epi>(g, n_skinny, E, first_block);
}

__device__ __forceinline__ void conv_tile(const float* __restrict__ src, int sld, int c0, int cvalid_end, int k0, int kend,
                          u16* __restrict__ dst, int dld, int r0, const float* __restrict__ gain) {
  extern __shared__ __attribute__((aligned(16))) float ctile[];
  const int tid = otid();
  __syncthreads();
  {
    const int j = tid & 63, i0 = tid >> 6;
    const bool cok = c0 + j < cvalid_end;
    float v[32];
#pragma unroll
    for (int e = 0; e < 32; ++e) {
      const int k = k0 + i0 + e * 8;
      v[e] = (cok && k < kend) ? src[(size_t)k * sld + c0 + j] : 0.f;
    }
    if (gain) {
#pragma unroll
      for (int e = 0; e < 32; ++e) { const int k = k0 + i0 + e * 8; v[e] *= (k < kend) ? gain[k] : 0.f; }
    }
#pragma unroll
    for (int e = 0; e < 32; ++e) ctile[(i0 + e * 8) * 65 + j] = v[e];
  }
  __syncthreads();
  {
    const int j = tid >> 3, ic = tid & 7;
#pragma unroll
    for (int q = 0; q < 4; ++q) {
      const int kk = (q * 8 + ic) * 8;
      if (k0 + kk < kend) {
        bf16x8 v;
#pragma unroll
        for (int e = 0; e < 8; ++e) v[e] = (short)f2bf(ctile[(kk + e) * 65 + j]);
        *(bf16x8*)(dst + (size_t)(r0 + j) * dld + k0 + kk) = v;
      }
    }
  }
}
__device__ __forceinline__ void conv_seg(const float* src, int sld, int c0, int ncols_valid, int ncols_pad, int K, u16* dst, int dld, int r0, const float* gain) {
  const int nct = ncols_pad / 64, nkt = (K + 255) / 256;
  for (int t = blockIdx.x; t < nct * nkt; t += gridDim.x) {
    const int ct = t % nct, kt = t / nct;
    conv_tile(src, sld, c0 + ct * 64, c0 + ncols_valid, kt * 256, K, dst, dld, r0 + ct * 64, gain);
  }
}

__device__ __forceinline__ void conv_ffn(PP p, int f, int t0, int stride, int tbeg = 0, int tend = 528) {
  unsigned char* ws = p->ws;
  const int l = f >> 1, s2 = f & 1;
  for (int t = tbeg + t0; t < tend; t += stride) {
    if (t < 352) {
      const int which = t & 1, n64 = (t >> 1) % 44, kt = (t >> 1) / 44;
      const float* src = p->in[(s2 ? 8 : 3) + which] + (size_t)l * 1024 * DFF;
      u16* dst = (u16*)(ws + WS_WGU + (size_t)f * WGU_ONE);
      conv_tile(src, DFF, n64 * 64, DFF, kt * 256, 1024, dst, 1024, (n64 >> 1) * 256 + which * 128 + (n64 & 1) * 64, p->in[s2 ? 7 : 2] + l * DM);
    } else {
      const int r = t - 352, ct = r % 16, kt = r / 16;
      const float* src = p->in[s2 ? 10 : 5] + (size_t)l * DFF * 1024;
      u16* dst = (u16*)(ws + WS_WD + (size_t)f * WD_ONE);
      conv_tile(src, 1024, ct * 64, 1024, kt * 256, DFF, dst, DFF, ct * 64, nullptr);
    }
  }
  __syncthreads();
}
__device__ __forceinline__ void conv_small(PP p) {
  unsigned char* ws = p->ws;
  for (int t = blockIdx.x; t < 256; t += gridDim.x) {
    const float* src; const float* gain = nullptr; u16* dst; int sld, c0, cend, k0, kend, dld, r0;
    if (t < 32) {
      const int i = t >> 2, ct = t & 3;
      src = p->in[11] + (size_t)i * 65536; sld = 256; c0 = ct * 64; cend = 256; k0 = 0; kend = 256;
      dst = (u16*)(ws + WS_WPOOL) + (size_t)i * 65536; dld = 256; r0 = ct * 64;
    } else if (t < 64) {
      const int r = t - 32, ct = r & 7, kt = r >> 3;
      src = p->in[14]; sld = 288; c0 = ct * 64; cend = 288; k0 = kt * 256; kend = 1024;
      dst = (u16*)(ws + WS_WDKV); dld = 1024; r0 = ct * 64; gain = p->in[13];
    } else if (t < 80) {
      const int r = t - 64, which = r >> 3, ct = r & 7;
      src = p->in[16 + which]; sld = 512; c0 = ct * 64; cend = 512; k0 = 0; kend = 256;
      dst = (u16*)(ws + WS_WUKV); dld = 256; r0 = which * 512 + ct * 64; gain = p->in[15];
    } else {
      const int r = (t - 80) % 88, j = (t - 80) / 88;
      if (r < 32) {
        const int ct = r & 7, kt = r >> 3;
        src = p->in[18] + (size_t)j * 1024 * 384; sld = 384; c0 = ct * 64; cend = 384; k0 = kt * 256; kend = 1024;
        dst = (u16*)(ws + WS_WDQ) + (size_t)j * 512 * 1024; dld = 1024; r0 = ct * 64; gain = p->in[6] + (2 + j) * DM;
      } else if (r < 56) {
        const int q = r - 32, ct = q % 12, kt = q / 12;
        src = p->in[20] + (size_t)j * 384 * 768; sld = 768; c0 = ct * 64; cend = 768; k0 = kt * 256; kend = 384;
        dst = (u16*)(ws + WS_WUQ) + (size_t)j * 768 * 384; dld = 384; r0 = ct * 64; gain = p->in[19] + j * 384;
      } else {
        const int q = r - 56, ct = q & 15, kt = q >> 4;
        src = p->in[21] + (size_t)j * 512 * 1024; sld = 1024; c0 = ct * 64; cend = 1024; k0 = kt * 256; kend = 512;
        dst = (u16*)(ws + WS_WO) + (size_t)j * 1024 * 512; dld = 512; r0 = ct * 64;
      }
    }
    conv_tile(src, sld, c0, cend, k0, kend, dst, dld, r0, gain);
  }
  __syncthreads();
}

template <int MODE>
__device__ __forceinline__ void norm_rows(PP p, const float* __restrict__ gain) {
  const int tid = otid(), wave = tid >> 6, lane = tid & 63;
  u16* HI = (u16*)(p->ws + WS_XN); u16* LO = (u16*)(p->ws + WS_LO);
  float* ss0 = (float*)(p->ws + WS_SS);
  const int nrows = (MODE == 2) ? MR : MALL;
  constexpr int NB = 4;
  const int stride = gridDim.x * 8;
  for (int row0 = blockIdx.x * 8 + wave; row0 < nrows; row0 += NB * stride) {
    f32x4 v[NB][4];
#pragma unroll
    for (int k = 0; k < NB; ++k) {
      const int row = row0 + k * stride;
      if (row < nrows) {
        if (MODE == 1) {
          const float* src = row < MR ? p->in[0] + (size_t)row * DM : p->in[1] + (size_t)(row - MR) * DM;
#pragma unroll
          for (int i = 0; i < 4; ++i) v[k][i] = ((const f32x4*)src)[i * 64 + lane];
        } else {
#pragma unroll
          for (int i = 0; i < 4; ++i) {
            const uint2 a = ((const uint2*)(HI + (size_t)row * DM))[i * 64 + lane], b = ((const uint2*)(LO + (size_t)row * DM))[i * 64 + lane];
            v[k][i] = hl_sum(a.x, a.y, b.x, b.y);
          }
        }
      } else {
#pragma unroll
        for (int i = 0; i < 4; ++i) v[k][i] = (f32x4){0.f, 0.f, 0.f, 0.f};
      }
    }
#pragma unroll
    for (int k = 0; k < NB; ++k) {
      const int row = row0 + k * stride;
      float ss = 0.f;
#pragma unroll
      for (int i = 0; i < 4; ++i) { const f32x4 q = v[k][i] * v[k][i]; ss += q[0] + q[1] + q[2] + q[3]; }
      ss = wave_sum(ss);
      if (row < nrows) {
        if (MODE == 1) {
          if (lane == 0) ss0[row] = ss;
#pragma unroll
          for (int i = 0; i < 4; ++i) {
            ushort4 hi, lo; hl_split(v[k][i], hi, lo);
            ((ushort4*)(HI + (size_t)row * DM))[i * 64 + lane] = hi;
            ((ushort4*)(LO + (size_t)row * DM))[i * 64 + lane] = lo;
          }
        } else {
          const float r = rsqrtf(ss * (1.f / DM) + EPS);
#pragma unroll
          for (int i = 0; i < 4; ++i) {
            const f32x4 g = ((const f32x4*)gain)[i * 64 + lane];
            ((f32x4*)(p->out + (size_t)row * DM))[i * 64 + lane] = v[k][i] * g * r;
          }
        }
      }
    }
  }
}

template <int W>
__device__ __forceinline__ void pool_seg(const u16* __restrict__ HB, const float* __restrict__ ss, const float* __restrict__ gain,
                                         u16* __restrict__ P, int b, int t0, int c8) {
  constexpr int NR = W - 1 + 8;
  bf16x8 v[NR]; float rr[NR];
#pragma unroll
  for (int j = 0; j < NR; ++j) {
    const int q = NMETA + t0 - (W - 1) + j;
    const int r = q >= NMETA ? b * SEQ + q - NMETA : MR + q;
    v[j] = *(const bf16x8*)(HB + (size_t)r * DM + c8 * 8);
    rr[j] = ss[r];
  }
  const f32x4 g0 = *(const f32x4*)(gain + c8 * 8), g1 = *(const f32x4*)(gain + c8 * 8 + 4);
  float S[8];
#pragma unroll
  for (int e = 0; e < 8; ++e) S[e] = 0.f;
#pragma unroll
  for (int j = 0; j < NR; ++j) {
    const float rj = rsqrtf(rr[j] * (1.f / DM) + EPS);
    float u[8];
#pragma unroll
    for (int e = 0; e < 8; ++e) { u[e] = bf2f((u16)v[j][e]) * rj; S[e] += u[e]; }
    if (j >= W - 1) {
      bf16x8 o;
#pragma unroll
      for (int e = 0; e < 8; ++e) o[e] = (short)f2bf((S[e] * (1.f / W) - u[e]) * (e < 4 ? g0[e & 3] : g1[e & 3]));
      *(bf16x8*)(P + (size_t)(b * SEQ + t0 + j - (W - 1)) * DM + c8 * 8) = o;
      const float ro = rsqrtf(rr[j - (W - 1)] * (1.f / DM) + EPS);
#pragma unroll
      for (int e = 0; e < 8; ++e) S[e] -= bf2f((u16)v[j - (W - 1)][e]) * ro;
    }
  }
}
__device__ __forceinline__ void pool_phase(const u16* __restrict__ HB, const float* __restrict__ ss, const float* __restrict__ gain, u16* __restrict__ P) {
  const int nitem = 4 * 2048 * 32;
  for (int i = blockIdx.x * NTHR + otid(); i < nitem; i += gridDim.x * NTHR) {
    const int c = i & 31, bseg = (i >> 5) & 2047, g = i >> 16;
    const int b = bseg >> 10, t0 = (bseg & 1023) * 8, c8 = g * 32 + c;
    if (g == 0) pool_seg<2>(HB, ss, gain, P, b, t0, c8);
    else if (g == 1) pool_seg<4>(HB, ss, gain, P, b, t0, c8);
    else if (g == 2) pool_seg<8>(HB, ss, gain, P, b, t0, c8);
    else pool_seg<16>(HB, ss, gain, P, b, t0, c8);
  }
  for (int idx = blockIdx.x * NTHR + otid(); idx < NMETA * 128; idx += gridDim.x * NTHR) {
    const int pos = idx >> 7, c8 = idx & 127, w = 2 << (c8 >> 5);
    const int cnt = min(w, pos + 1);
    float acc[8], self[8];
#pragma unroll
    for (int e = 0; e < 8; ++e) { acc[e] = 0.f; self[e] = 0.f; }
    bf16x8 v[16]; float rr[16];
#pragma unroll
    for (int j = 0; j < 16; ++j) {
      v[j] = (bf16x8){0, 0, 0, 0, 0, 0, 0, 0}; rr[j] = 1.f;
      if (j < cnt) { const int r = MR + pos - j; v[j] = *(const bf16x8*)(HB + (size_t)r * DM + c8 * 8); rr[j] = ss[r]; }
    }
#pragma unroll
    for (int j = 0; j < 16; ++j) {
      const float rj = (j < cnt) ? rsqrtf(rr[j] * (1.f / DM) + EPS) : 0.f;
#pragma unroll
      for (int e = 0; e < 8; ++e) { const float f = bf2f((u16)v[j][e]) * rj; acc[e] += f; if (j == 0) self[e] = f; }
    }
    const float inv = 1.f / (float)cnt;
    const f32x4 g0 = *(const f32x4*)(gain + c8 * 8), g1 = *(const f32x4*)(gain + c8 * 8 + 4);
    bf16x8 o;
#pragma unroll
    for (int e = 0; e < 8; ++e) o[e] = (short)f2bf((acc[e] * inv - self[e]) * (e < 4 ? g0[e & 3] : g1[e & 3]));
    *(bf16x8*)(P + (size_t)(MR + pos) * DM + c8 * 8) = o;
  }
}

constexpr int KPITCH = 208, VPITCH = 144, KBYTES = 64 * KPITCH, ABUF = KBYTES + 64 * VPITCH;
__device__ __forceinline__ void attn_block(PP p, int b, int h, int qb) {
  extern __shared__ __attribute__((aligned(16))) unsigned char alds[];
  const int tid = otid(), wave = tid >> 6, lane = tid & 63, l32 = lane & 31, hl = lane >> 5;
  const u16* Q = (const u16*)(p->ws + WS_G + GA_Q);
  u16* O = (u16*)(p->ws + WS_G + GA_O);
  const bool meta = qb < 0;
  int qrow, cw, cmax;
  if (!meta) { qrow = b * SEQ + qb * 256 + wave * 32 + l32; cw = qb * 4 + (wave >> 1); cmax = qb * 4 + 3; }
  else { qrow = MR + min(l32, 15); cw = (wave == 0) ? -1 : -2; cmax = -1; }
  bf16x8 qf[6];
  {
    const u16* qp = Q + (size_t)qrow * 768 + h * 96 + hl * 8;
#pragma unroll
    for (int ks = 0; ks < 6; ++ks) qf[ks] = *(const bf16x8*)(qp + ks * 16);
  }
  f32x16 o0, o1;
#pragma unroll
  for (int i = 0; i < 16; ++i) { o0[i] = 0.f; o1[i] = 0.f; }
  float mrun = -1e30f, lsum = 0.f;
  const u16* Kg = (const u16*)p->out + (size_t)((b * 8 + h) * SEQ) * 96;
  const u16* Vg = (const u16*)p->out + KF_ELEMS + (size_t)((b * 8 + h) * 64) * SEQ;
  const u16* Kmg = (const u16*)(p->ws + WS_KM) + h * 64 * 96;
  const u16* Vmg = (const u16*)(p->ws + WS_VM) + h * 64 * 64;
  const int vdv = tid >> 3, vpart = tid & 7;
  const int kw0 = (tid / 12) * KPITCH + (tid % 12) * 16;
  const int kw1 = ((tid + 512) / 12) * KPITCH + ((tid + 512) % 12) * 16;
  const int vw = KBYTES + vdv * VPITCH + vpart * 16;
  uint4 kr0, kr1 = make_uint4(0, 0, 0, 0), vr;
#define ATT_LOAD(kt) do { const uint4* ks_ = (const uint4*)((kt) < 0 ? Kmg : Kg + (size_t)(kt) * 64 * 96); \
    kr0 = ks_[tid]; if (tid < 256) kr1 = ks_[tid + 512]; \
    vr = *(const uint4*)((kt) < 0 ? Vmg + vdv * 64 + vpart * 8 : Vg + (size_t)vdv * SEQ + (kt) * 64 + vpart * 8); } while (0)
#define ATT_WRITE(buf) do { unsigned char* b_ = alds + (buf) * ABUF; *(uint4*)(b_ + kw0) = kr0; if (tid < 256) *(uint4*)(b_ + kw1) = kr1; \
    *(uint4*)(b_ + vw) = vr; } while (0)
  ATT_LOAD(-1);
  ATT_WRITE(0);
  __syncthreads();
  int it = 0;
  for (int kt = -1; kt <= cmax; ++kt, ++it) {
    const int buf = it & 1;
    if (kt < cmax) ATT_LOAD(kt + 1);
    if (kt <= cw) {
      const unsigned char* kb = alds + buf * ABUF;
      const unsigned char* vb = kb + KBYTES;
      f32x16 s0, s1;
#pragma unroll
      for (int i = 0; i < 16; ++i) { s0[i] = 0.f; s1[i] = 0.f; }
#pragma unroll
      for (int ks = 0; ks < 6; ++ks) {
        const bf16x8 k0 = *(const bf16x8*)(kb + l32 * KPITCH + ks * 32 + hl * 16);
        const bf16x8 k1 = *(const bf16x8*)(kb + (32 + l32) * KPITCH + ks * 32 + hl * 16);
        s0 = __builtin_amdgcn_mfma_f32_32x32x16_bf16(k0, qf[ks], s0, 0, 0, 0);
        s1 = __builtin_amdgcn_mfma_f32_32x32x16_bf16(k1, qf[ks], s1, 0, 0, 0);
      }
      if (kt < 0) {
#pragma unroll
        for (int i = 8; i < 16; ++i) s0[i] = -1e30f;
#pragma unroll
        for (int i = 0; i < 16; ++i) s1[i] = -1e30f;
      }
      float mx = s0[0];
#pragma unroll
      for (int i = 1; i < 16; ++i) mx = fmaxf(mx, s0[i]);
#pragma unroll
      for (int i = 0; i < 16; ++i) mx = fmaxf(mx, s1[i]);
      mx = xhalf_max(mx);
      const float mnew = fmaxf(mrun, mx);
      const float alpha = __builtin_amdgcn_exp2f(mrun - mnew);
      mrun = mnew;
      float ps = 0.f;
#pragma unroll
      for (int i = 0; i < 16; ++i) { s0[i] = __builtin_amdgcn_exp2f(s0[i] - mnew); ps += s0[i]; }
#pragma unroll
      for (int i = 0; i < 16; ++i) { s1[i] = __builtin_amdgcn_exp2f(s1[i] - mnew); ps += s1[i]; }
      lsum = lsum * alpha + ps;
#pragma unroll
      for (int i = 0; i < 16; ++i) { o0[i] *= alpha; o1[i] *= alpha; }
#pragma unroll
      for (int jp = 0; jp < 4; ++jp) {
        bf16x8 pf;
#pragma unroll
        for (int e = 0; e < 8; ++e) pf[e] = (short)f2bf((jp < 2) ? s0[(jp & 1) * 8 + e] : s1[(jp & 1) * 8 + e]);
        const bf16x8 v0 = *(const bf16x8*)(vb + l32 * VPITCH + (jp * 16 + hl * 8) * 2);
        const bf16x8 v1 = *(const bf16x8*)(vb + (32 + l32) * VPITCH + (jp * 16 + hl * 8) * 2);
        o0 = __builtin_amdgcn_mfma_f32_32x32x16_bf16(v0, pf, o0, 0, 0, 0);
        o1 = __builtin_amdgcn_mfma_f32_32x32x16_bf16(v1, pf, o1, 0, 0, 0);
        }
    }
    if (kt < cmax) ATT_WRITE(buf ^ 1);
    __syncthreads();
  }
#undef ATT_LOAD
#undef ATT_WRITE
  const float ltot = xhalf_sum(lsum);
  if (cw >= -1 && (!meta || l32 < 16)) {
    const float inv = 1.f / ltot;
    u16* op = O + (size_t)qrow * 512 + h * 64 + 4 * hl;
#pragma unroll
    for (int g4 = 0; g4 < 4; ++g4) {
      ushort4 a, c;
      a.x = f2bf(o0[g4 * 4 + 0] * inv); a.y = f2bf(o0[g4 * 4 + 1] * inv); a.z = f2bf(o0[g4 * 4 + 2] * inv); a.w = f2bf(o0[g4 * 4 + 3] * inv);
      c.x = f2bf(o1[g4 * 4 + 0] * inv); c.y = f2bf(o1[g4 * 4 + 1] * inv); c.z = f2bf(o1[g4 * 4 + 2] * inv); c.w = f2bf(o1[g4 * 4 + 3] * inv);
      *(ushort4*)(op + 8 * g4) = a;
      *(ushort4*)(op + 32 + 8 * g4) = c;
    }
  }
}

__device__ __forceinline__ void attn_phase(PP p) {
  const int G = gridDim.x;
  for (int it = blockIdx.x; it < 256; it += G) {
    const int nsub = it < 256 ? 2 : 1;
    for (int sub = 0; sub < nsub; ++sub) {
      int b, h, qb;
      if (it < 256) { const int bh = it >> 4, i = it & 15; b = bh >> 3; h = bh & 7; qb = sub ? i : 31 - i; }
      else { b = 0; h = it - 256; qb = -1; }
      attn_block(p, b, h, qb);
    }
  }
}

__device__ __forceinline__ void misc_init(PP p) {
  float2* rope = (float2*)(p->ws + WS_ROPE);
  for (int idx = blockIdx.x * NTHR + otid(); idx < 8208 * 16; idx += gridDim.x * NTHR) {
    const int pos = idx >> 4, i = idx & 15;
    const float inv = 1.0f / powf(10000.f, (float)(2 * i) / 32.f);
    const float ang = (float)pos * inv;
    float s, c; sincosf(ang, &s, &c);
    rope[idx] = make_float2(c, s);
  }
  unsigned* z = (unsigned*)(p->ws + WS_KM);
  const int nz = (int)((WS_HM - WS_KM) / 4);
  for (int idx = blockIdx.x * NTHR + otid(); idx < nz; idx += gridDim.x * NTHR) z[idx] = 0u;
  unsigned* zs = (unsigned*)(p->ws + WS_SS) + SSLD;
  for (int idx = blockIdx.x * NTHR + otid(); idx < (NSLOT - 1) * SSLD; idx += gridDim.x * NTHR) zs[idx] = 0u;
}

#define XB_TMO      128
#define XB_XCNT(j)  (256  + 64 * (j))
#define XB_XSUB(j)  (1280 + 64 * (j))
#define XB_XGEN(j)  (2304 + 64 * (j))
#define XB_TOP      3328
#define XB_TOPGEN   3392
#define XCD_BAR_WORDS 3456
#define XB_SPIN_CAP (1u << 20)
DI unsigned xb_ld(unsigned* p)              { return __hip_atomic_load(p, __ATOMIC_RELAXED, __HIP_MEMORY_SCOPE_AGENT); }
DI unsigned xb_add(unsigned* p, unsigned v) { return __hip_atomic_fetch_add(p, v, __ATOMIC_RELAXED, __HIP_MEMORY_SCOPE_AGENT); }
DI unsigned xb_xcc_id() { return (unsigned)__builtin_amdgcn_s_getreg((3 << 11) | 20) & 0xFu; }
#define XB_SPIN(cond, bar) do { unsigned _sp = 0; while (cond) { __builtin_amdgcn_s_sleep(1); \
    if ((++_sp & 255u) == 0u) { if (xb_ld(&(bar)[XB_TMO])) break; if (_sp > XB_SPIN_CAP) { atomicAdd(&(bar)[XB_TMO], 1u); break; } } } } while (0)
struct XcdBarrier { unsigned* bar; unsigned x; volatile LAS unsigned* st; };
DI XcdBarrier xcd_barrier_post(unsigned* bar, volatile LAS unsigned* st) {
  XcdBarrier b; b.bar = bar; b.x = xb_xcc_id(); b.st = st;
  if (threadIdx.x == 0) (void)xb_add(&bar[XB_XCNT(b.x)], 1u);
  return b;
}
DI void xcd_barrier_complete(unsigned* bar, unsigned x, unsigned& nloc, unsigned& nx) {
  const unsigned G = gridDim.x * gridDim.y * gridDim.z;
  unsigned sum, cnt, mine, sp = 0u;
  for (;;) {
    sum = 0u; cnt = 0u; mine = 0u;
#pragma unroll
    for (unsigned j = 0; j < 16; ++j) { const unsigned c = xb_ld(&bar[XB_XCNT(j)]); sum += c; cnt += (c > 0u) ? 1u : 0u; mine = (j == x) ? c : mine; }
    if (sum == G) break;
    __builtin_amdgcn_s_sleep(1);
    if ((++sp & 255u) == 0u) { if (xb_ld(&bar[XB_TMO])) break; if (sp > XB_SPIN_CAP) { atomicAdd(&bar[XB_TMO], 1u); break; } }
  }
  nloc = mine > 0u ? mine : 1u; nx = cnt > 0u ? cnt : 1u;
}
DI void xcd_barrier(const XcdBarrier& b) {
  asm volatile("s_waitcnt vmcnt(0)" ::: "memory");
  __syncthreads();
  if (threadIdx.x == 0) {
    unsigned* bar = b.bar;
    __builtin_amdgcn_s_waitcnt(0);
    unsigned nloc = b.st[0], nx = b.st[1];
    if (nloc == 0u) { xcd_barrier_complete(bar, b.x, nloc, nx); b.st[0] = nloc; b.st[1] = nx; }
    const unsigned old = xb_add(&bar[XB_XSUB(b.x)], 1u);
    const unsigned gen = old / nloc;
    if (old + 1u == (gen + 1u) * nloc) {
      __builtin_amdgcn_fence(__ATOMIC_RELEASE, "agent");
      asm volatile("s_waitcnt vmcnt(0)" ::: "memory");
      const unsigned og = xb_add(&bar[XB_TOP], 1u);
      const unsigned tg = og / nx;
      if (og + 1u == (tg + 1u) * nx) xb_add(&bar[XB_TOPGEN], 1u);
      else XB_SPIN(xb_ld(&bar[XB_TOPGEN]) == tg, bar);
      __builtin_amdgcn_fence(__ATOMIC_ACQUIRE, "agent");
      xb_add(&bar[XB_XGEN(b.x)], 1u);
      asm volatile("s_waitcnt vmcnt(0)" ::: "memory");
    } else {
      XB_SPIN(xb_ld(&bar[XB_XGEN(b.x)]) == gen, bar);
      __builtin_amdgcn_fence(__ATOMIC_ACQUIRE, "agent");
      asm volatile("s_waitcnt vmcnt(0)" ::: "memory");
    }
  }
  __syncthreads();
}

#define GSYNC() do { xcd_barrier(xb); p = launder(p); } while (0)
__device__ __forceinline__ void ffn(PP p, int f, int sin, int sout, const XcdBarrier& xb, bool with_kv, bool meta) {
  if (with_kv) {
    unsigned char* ws = p->ws; float* SS = (float*)(ws + WS_SS);
    EpiDKV E{(u16*)(ws + WS_CKV), SS + (size_t)sin * SSLD, SS + (size_t)SLOT_KV * SSLD, (const float*)(ws + WS_ROPE), (u16*)p->out, (u16*)(ws + WS_KM)};
    gemm_all<EpiDKV>(Gemm{(const u16*)(ws + WS_XN), (const u16*)(ws + WS_WDKV), 1024, 1024, 1024, 2, 0, 128}, 9, E);
  }
  {
    unsigned char* ws = p->ws;
    EpiSwiglu E{(u16*)(ws + WS_G), (const float*)(ws + WS_SS) + (size_t)sin * SSLD};
    gemm_all<EpiSwiglu>(Gemm{(const u16*)(ws + WS_XN), (const u16*)(ws + WS_WGU + (size_t)f * WGU_ONE), 1024, 1024, 1024, 22, 0, 0}, meta ? DFF / 16 : 0, E, ogdim() == 256 ? 128 : 0);
    if (f < 7) { const int gd = ogdim(), bid = obid();
      if (gd == 256) { if (bid >= 128) { if (f == 0) conv_ffn(p, 0, bid - 128, 128, 352, 528); conv_ffn(p, f + 1, bid - 128, 128); } }
      else { if (f == 0) conv_ffn(p, 0, bid, gd, 352, 528); conv_ffn(p, f + 1, bid, gd); } }
    if (DUP_GU) { xcd_barrier(xb); gemm_phase<EpiSwiglu>(Gemm{(const u16*)(ws + WS_XN), (const u16*)(ws + WS_WGU + (size_t)f * WGU_ONE), 1024, 1024, 1024, 22, 0, 0}, E); }
    if (DUP_SKINNY) { xcd_barrier(xb); skinny<EpiSwiglu>(Gemm{(const u16*)(ws + WS_XN), (const u16*)(ws + WS_WGU + (size_t)f * WGU_ONE), 1024, 1024, 1024, 22, 0, 0}, DFF / 16, E); }
  }
  GSYNC();
  {
    unsigned char* ws = p->ws;
    EpiResidT<false> E{(u16*)(ws + WS_XN), (u16*)(ws + WS_LO), (float*)(ws + WS_SS) + (size_t)sout * SSLD, nullptr, 0.5f};
    gemm_all<EpiResidT<false>>(Gemm{(const u16*)(ws + WS_G), (const u16*)(ws + WS_WD + (size_t)f * WD_ONE), DFF, DFF, DFF, 4, 0, 0}, meta ? 1024 / 32 : 0, E);
  }
  if (with_kv) {
    unsigned char* ws = p->ws; float* SS = (float*)(ws + WS_SS);
    EpiKV E{(u16*)p->out, (u16*)p->out + KF_ELEMS, (u16*)(ws + WS_KM), (u16*)(ws + WS_VM), SS + (size_t)SLOT_KV * SSLD};
    gemm_all<EpiKV>(Gemm{(const u16*)(ws + WS_CKV), (const u16*)(ws + WS_WUKV), 256, 256, 256, 4, 0, 0}, 32, E);
  }
  GSYNC();
}

__global__ void __launch_bounds__(NTHR, 2) mega(Params p_unused) {
  extern __shared__ __attribute__((aligned(16))) unsigned char shm_top[];
  cg::grid_group grid = cg::this_grid();
  PP p = launder((PP)__builtin_amdgcn_kernarg_segment_ptr());

  {
    unsigned* bw = (unsigned*)(p->ws + WS_BAR);
    for (int idx = blockIdx.x * NTHR + otid(); idx < XCD_BAR_WORDS; idx += gridDim.x * NTHR) bw[idx] = 0u;
    if (threadIdx.x < 4) ((volatile LAS unsigned*)((LAS unsigned char*)shm_top + SHM_B))[threadIdx.x] = 0u;
  }
  conv_ffn(p, 0, blockIdx.x, gridDim.x, 0, 352);
  conv_small(p);
  misc_init(p);
  norm_rows<1>(p, nullptr);
  grid.sync();
  p = launder(p);
  const XcdBarrier xb = xcd_barrier_post((unsigned*)(p->ws + WS_BAR), (volatile LAS unsigned*)((LAS unsigned char*)shm_top + SHM_B));

  for (int l = 0; l < DEPTH; ++l) {
    ffn(p, l * 2, 3 * l, 3 * l + 1, xb, l == 2, l < 2);
    unsigned char* ws = p->ws;
    float* SS = (float*)(ws + WS_SS);
    u16* HB = (u16*)(ws + WS_XN);
    float* Hm = (float*)(ws + WS_HM);
    if (l < 2) {
      u16* P = (u16*)(ws + WS_G + GA_P);
      pool_phase(HB, SS + (size_t)(3 * l + 1) * SSLD, p->in[6] + l * DM, P);
      GSYNC();
      ws = p->ws; SS = (float*)(ws + WS_SS); HB = (u16*)(ws + WS_XN); Hm = (float*)(ws + WS_HM); P = (u16*)(ws + WS_G + GA_P);
      {
        EpiResidT<true> E{HB, (u16*)(ws + WS_LO), SS + (size_t)(3 * l + 2) * SSLD, p->in[12] + l * DM, 1.f};
        gemm_all<EpiResidT<true>>(Gemm{P, (const u16*)(ws + WS_WPOOL) + (size_t)l * 4 * 65536, 1024, 256, 256, 4, 256, 0}, 32, E);
      }
      GSYNC();
    } else {
      const int j = l - 2;
      {
        EpiDQ E{(u16*)(ws + WS_G + GA_CQN), SS + (size_t)(3 * l + 1) * SSLD, SS + (size_t)(SLOT_Q + j) * SSLD};
        gemm_all<EpiDQ>(Gemm{HB, (const u16*)(ws + WS_WDQ) + (size_t)j * 512 * 1024, 1024, 1024, 1024, 2, 0, 0}, 0, E);
      }
      GSYNC();
      ws = p->ws; SS = (float*)(ws + WS_SS);
      {
        EpiQ E{(u16*)(ws + WS_G + GA_Q), (const float*)(ws + WS_ROPE), SS + (size_t)(SLOT_Q + j) * SSLD, 0.10206207261596577f * 1.4426950408889634f};
        gemm_all<EpiQ>(Gemm{(const u16*)(ws + WS_G + GA_CQN), (const u16*)(ws + WS_WUQ) + (size_t)j * 768 * 384, 384, 384, 384, 3, 0, 0}, 0, E);
      }
      GSYNC();
      attn_phase(p);
      if (DUP_ATTN) { GSYNC(); attn_phase(p); }
      GSYNC();
      ws = p->ws; SS = (float*)(ws + WS_SS); HB = (u16*)(ws + WS_XN); Hm = (float*)(ws + WS_HM);
      {
        EpiResidT<false> E{HB, (u16*)(ws + WS_LO), SS + (size_t)(3 * l + 2) * SSLD, nullptr, 1.f};
        gemm_all<EpiResidT<false>>(Gemm{(const u16*)(ws + WS_G + GA_O), (const u16*)(ws + WS_WO) + (size_t)j * 1024 * 512, 512, 512, 512, 4, 0, 0}, 0, E);
      }
      GSYNC();
    }
    ffn(p, l * 2 + 1, 3 * l + 2, 3 * l + 3, xb, false, l < 2);
  }
  norm_rows<2>(p, p->in[22]);
}

extern "C" void kernel_launch(void* const* d_in, const int* in_sizes, int n_in, void* d_out, int out_size,
                              void* d_ws, size_t ws_size, hipStream_t stream) {
  static int grid_blocks = 0;
  if (grid_blocks == 0) {
    if (n_in != 23 || out_size != MR * DM || ws_size < WS_END) {
      fprintf(stderr, "kernel_launch: unexpected problem (n_in %d out %d ws %zu need %zu)\n", n_in, out_size, ws_size, (size_t)WS_END);
      grid_blocks = -1; return;
    }
    int dev = 0, cus = 0, per_cu = 0;
    hipGetDevice(&dev);
    hipDeviceGetAttribute(&cus, hipDeviceAttributeMultiprocessorCount, dev);
    hipFuncSetAttribute((const void*)mega, hipFuncAttributeMaxDynamicSharedMemorySize, SHM_B + 16);
    hipOccupancyMaxActiveBlocksPerMultiprocessor(&per_cu, (const void*)mega, NTHR, SHM_B + 16);
    if (per_cu < 1) { fprintf(stderr, "kernel_launch: occupancy query says %d blocks/CU\n", per_cu); per_cu = 1; }
    grid_blocks = cus * 1;
    (void)hipGetLastError();
  }
  if (grid_blocks < 0) return;
  Params hp{};
  for (int i = 0; i < 23; ++i) hp.in[i] = (const float*)d_in[i];
  hp.out = (float*)d_out; hp.ws = (unsigned char*)d_ws;
  void* args[] = {&hp};
  hipError_t e = hipLaunchCooperativeKernel((const void*)mega, dim3(grid_blocks), dim3(NTHR), args, SHM_B + 16, stream);
  if (e != hipSuccess) fprintf(stderr, "cooperative launch failed: %s (grid %d)\n", hipGetErrorString(e), grid_blocks);
}
```

```cpp
#include <hip/hip_runtime.h>
#include <hip/hip_bf16.h>
#include <hip/hip_cooperative_groups.h>
#include <cstdio>
namespace cg = cooperative_groups;

typedef unsigned short u16;
using bf16x8 = __attribute__((ext_vector_type(8))) short;
using f32x4 = __attribute__((ext_vector_type(4))) float;
using f32x16 = __attribute__((ext_vector_type(16))) float;
#define DI __device__ __forceinline__

constexpr int DM = 1024, SEQ = 8192, MR = 16384, NMETA = 16, MALL = MR + NMETA, MPAD = 16640;
constexpr int DFF = 2816, DEPTH = 4;
constexpr int NTHR = 512;
#define DUP_CONV 0
#define DUP_ATTN 0
#define DUP_GU 0
#define DUP_SKINNY 0
constexpr float EPS = 1e-6f;

constexpr size_t al256(size_t x) { return (x + 255) & ~(size_t)255; }
constexpr size_t WS_XN = 0;
constexpr size_t WS_G = WS_XN + al256((size_t)MPAD * 1024 * 2);
constexpr size_t G_BYTES = (size_t)MPAD * DFF * 2;
constexpr size_t WS_WGU = WS_G + al256(G_BYTES);
constexpr size_t WGU_ONE = (size_t)2 * DFF * 1024 * 2;
constexpr size_t WS_WD = WS_WGU + 8 * WGU_ONE;
constexpr size_t WD_ONE = (size_t)1024 * DFF * 2;
constexpr size_t WS_WPOOL = WS_WD + 8 * WD_ONE;
constexpr size_t WS_WDKV = WS_WPOOL + (size_t)8 * 65536 * 2;
constexpr size_t WS_WUKV = WS_WDKV + (size_t)512 * 1024 * 2;
constexpr size_t WS_WDQ = WS_WUKV + (size_t)1024 * 256 * 2;
constexpr size_t WS_WUQ = WS_WDQ + (size_t)2 * 512 * 1024 * 2;
constexpr size_t WS_WO = WS_WUQ + (size_t)2 * 768 * 384 * 2;
constexpr size_t WS_KF = WS_WO + (size_t)2 * 1024 * 512 * 2;
constexpr size_t WS_LO = WS_KF;
constexpr size_t WS_VT = WS_KF + (size_t)2 * 8 * 8192 * 96 * 2;
constexpr size_t WS_KM = WS_VT + (size_t)2 * 8 * 64 * 8192 * 2;
constexpr size_t WS_VM = WS_KM + (size_t)8 * 64 * 96 * 2;
constexpr size_t WS_HM = WS_VM + (size_t)8 * 64 * 64 * 2;
constexpr size_t WS_ROPE = WS_HM + (size_t)16 * 1024 * 4;
constexpr size_t WS_SS = WS_ROPE + al256((size_t)8208 * 16 * 8);
constexpr int NSLOT = 16, SSLD = 16512, SLOT_Q = 13, SLOT_KV = 15;
constexpr size_t WS_CKV = WS_SS + (size_t)NSLOT * SSLD * 4;
constexpr size_t WS_BAR = WS_CKV + al256((size_t)MPAD * 256 * 2);
constexpr size_t WS_END = WS_BAR + 16384;
constexpr size_t GA_P = 0;
constexpr size_t GA_CQ = 0;
constexpr size_t GA_CQN = al256((size_t)MPAD * 384 * 4);
constexpr size_t GA_Q = GA_CQN + al256((size_t)MPAD * 384 * 2);
constexpr size_t GA_O = GA_Q + al256((size_t)MPAD * 768 * 2);
static_assert(GA_O + (size_t)MPAD * 512 * 2 <= G_BYTES, "alias overflow");
static_assert((size_t)MPAD * 1024 * 2 <= (size_t)2 * 8 * 8192 * 96 * 2 + (size_t)2 * 8 * 64 * 8192 * 2, "LO must fit the old K/V region");
constexpr size_t KF_ELEMS = (size_t)2 * 8 * 8192 * 96;
static_assert((KF_ELEMS + (size_t)2 * 8 * 64 * 8192) * 2 <= (size_t)MR * DM * 4, "K/V must fit d_out");

struct Params { const float* in[23]; float* out; unsigned char* ws; };
typedef const __attribute__((address_space(4))) Params* PP;
__device__ __forceinline__ PP launder(PP q) {
  unsigned long long v = (unsigned long long)q;
  unsigned lo = __builtin_amdgcn_readfirstlane((unsigned)v), hi = __builtin_amdgcn_readfirstlane((unsigned)(v >> 32));
  asm volatile("" : "+s"(lo), "+s"(hi));
  return (PP)(((unsigned long long)hi << 32) | lo);
}

__device__ __forceinline__ int ogdim() { int g = __builtin_amdgcn_readfirstlane(gridDim.x); asm volatile("" : "+s"(g)); return g; }
__device__ __forceinline__ int obid() { int b = __builtin_amdgcn_readfirstlane(blockIdx.x); asm volatile("" : "+s"(b)); return b; }
__device__ __forceinline__ int otid() { int t = threadIdx.x; asm volatile("" : "+v"(t)); return t; }
DI u16 f2bf(float x) { return __builtin_bit_cast(u16, (__bf16)x); }
DI float bf2f(u16 v) { return __uint_as_float(((unsigned)v) << 16); }
DI float xhalf_max(float v) {
  const unsigned u = __float_as_uint(v);
  const auto r = __builtin_amdgcn_permlane32_swap(u, u, false, false);
  return fmaxf(__uint_as_float(r[0]), __uint_as_float(r[1]));
}
DI float xhalf_sum(float v) {
  const unsigned u = __float_as_uint(v);
  const auto r = __builtin_amdgcn_permlane32_swap(u, u, false, false);
  return __uint_as_float(r[0]) + __uint_as_float(r[1]);
}
DI float wave_sum(float v) {
  for (int o = 32; o > 0; o >>= 1) v += __shfl_xor(v, o);
  return v;
}
DI float silu_mul(float g, float u) { return g * __builtin_amdgcn_rcpf(1.f + __expf(-g)) * u; }
DI int row_pos(int row) { return row < MR ? (row & (SEQ - 1)) + NMETA : row - MR; }
DI int permt(int t) { return (t & ~12) | ((t & 4) << 1) | ((t & 8) >> 1); }

DI f32x4 hl_sum(unsigned h01, unsigned h23, unsigned l01, unsigned l23) {
  f32x4 r;
  r[0] = __uint_as_float(h01 << 16) + __uint_as_float(l01 << 16);
  r[1] = __uint_as_float(h01 & 0xffff0000u) + __uint_as_float(l01 & 0xffff0000u);
  r[2] = __uint_as_float(h23 << 16) + __uint_as_float(l23 << 16);
  r[3] = __uint_as_float(h23 & 0xffff0000u) + __uint_as_float(l23 & 0xffff0000u);
  return r;
}
DI void hl_split(f32x4 h, ushort4& hi, ushort4& lo) {
  hi = (ushort4){f2bf(h[0]), f2bf(h[1]), f2bf(h[2]), f2bf(h[3])};
  lo.x = f2bf(h[0] - bf2f(hi.x)); lo.y = f2bf(h[1] - bf2f(hi.y)); lo.z = f2bf(h[2] - bf2f(hi.z)); lo.w = f2bf(h[3] - bf2f(hi.w));
}
DI float* hrow_ptr(float* Hr, float* Hm, int row) { return row < MR ? Hr + (size_t)row * DM : Hm + (size_t)(row - MR) * DM; }
DI float rs_of(const float* ss, int row, float invn) { return rsqrtf(ss[row] * invn + EPS); }
DI ushort4 pk4(f32x4 v) { ushort4 o; o.x = f2bf(v[0]); o.y = f2bf(v[1]); o.z = f2bf(v[2]); o.w = f2bf(v[3]); return o; }
DI void row_ss_add(float* ss, int row, float part, bool valid) {
  part += __shfl_xor(part, 16); part += __shfl_xor(part, 32);
  if (valid && (__lane_id() < 16)) atomicAdd(ss + row, part);
}
DI f32x4 swiglu4(f32x4 g, f32x4 u, float r) {
  const float a = -1.4426950408889634f * r, b = r * r;
  const f32x4 t = g * a;
  f32x4 d;
  d[0] = __builtin_amdgcn_rcpf(1.f + __builtin_amdgcn_exp2f(t[0])); d[1] = __builtin_amdgcn_rcpf(1.f + __builtin_amdgcn_exp2f(t[1]));
  d[2] = __builtin_amdgcn_rcpf(1.f + __builtin_amdgcn_exp2f(t[2])); d[3] = __builtin_amdgcn_rcpf(1.f + __builtin_amdgcn_exp2f(t[3]));
  return (g * u) * (d * b);
}
struct EpiSwiglu {
  static constexpr bool GU = true, PERM = true;
  u16* G; const float* ssin;
  DI void colpre(int, f32x4&, f32x4&) const {}
  DI void pre(int row, int, float& r, f32x4&, f32x4&) const { r = ssin[row]; }
  DI void op(int row, int col, f32x4 g, f32x4 u, float r) const {
    r = rsqrtf(r * (1.f / DM) + EPS);
    *(ushort4*)(G + (size_t)row * DFF + col) = pk4(swiglu4(g, u, r));
  }
  DI void op8(int row, int col, f32x4 g0, f32x4 u0, f32x4 g1, f32x4 u1, float r) const {
    r = rsqrtf(r * (1.f / DM) + EPS);
    const ushort4 a = pk4(swiglu4(g0, u0, r)), b = pk4(swiglu4(g1, u1, r));
    bf16x8 o = {(short)a.x, (short)a.y, (short)a.z, (short)a.w, (short)b.x, (short)b.y, (short)b.z, (short)b.w};
    *(bf16x8*)(G + (size_t)row * DFF + col) = o;
  }
};
struct EpiNull {
  static constexpr bool GU = true, PERM = true;
  u16* G;
  DI void colpre(int, f32x4&, f32x4&) const {}
  DI void pre(int, int, float&, f32x4&, f32x4&) const {}
  DI void op(int row, int col, f32x4 g, f32x4 u, float) const { if (g[0] + u[1] + g[2] + u[3] == 12345.678f) G[(size_t)row * DFF + col] = 1; }
  DI void op8(int row, int col, f32x4 g, f32x4 u, f32x4, f32x4, float) const { if (g[0] + u[1] + g[2] + u[3] == 12345.678f) G[(size_t)row * DFF + col] = 1; }
};
template <bool HAS_CS>
struct EpiResidT {
  static constexpr bool GU = false, PERM = true;
  static constexpr int BATCH_ROWS = HAS_CS ? 2 : 4;
  u16* HI; u16* LO; float* ssout; const float* cs; float scale;
  template <int D1> DI void colpre(int col, f32x4& c0, f32x4& c1) const {
    c0 = (f32x4){scale, scale, scale, scale}; c1 = c0;
    if (HAS_CS) { c0 *= *(const f32x4*)(cs + col); c1 *= *(const f32x4*)(cs + col + D1); }
  }
  template <int D1> DI void pre(int row, int col, float&, f32x4& x0, f32x4& x1) const {
    const size_t o = (size_t)row * DM + col;
    if (D1 == 4) { x0 = *(const f32x4*)(HI + o); x1 = *(const f32x4*)(LO + o); }
    else {
      const uint2 a = *(const uint2*)(HI + o), b = *(const uint2*)(LO + o), c = *(const uint2*)(HI + o + D1), d = *(const uint2*)(LO + o + D1);
      x0 = (f32x4){__uint_as_float(a.x), __uint_as_float(a.y), __uint_as_float(b.x), __uint_as_float(b.y)};
      x1 = (f32x4){__uint_as_float(c.x), __uint_as_float(c.y), __uint_as_float(d.x), __uint_as_float(d.y)};
    }
  }
  template <int D1> DI void op(int row, int col, f32x4 v0, f32x4 v1, float, f32x4 x0, f32x4 x1, f32x4 c0, f32x4 c1) const {
    const size_t o = (size_t)row * DM + col;
    f32x4 h0, h1;
    if (D1 == 4) {
      h0 = hl_sum(__float_as_uint(x0[0]), __float_as_uint(x0[1]), __float_as_uint(x1[0]), __float_as_uint(x1[1])) + c0 * v0;
      h1 = hl_sum(__float_as_uint(x0[2]), __float_as_uint(x0[3]), __float_as_uint(x1[2]), __float_as_uint(x1[3])) + c1 * v1;
    } else {
      h0 = hl_sum(__float_as_uint(x0[0]), __float_as_uint(x0[1]), __float_as_uint(x0[2]), __float_as_uint(x0[3])) + c0 * v0;
      h1 = hl_sum(__float_as_uint(x1[0]), __float_as_uint(x1[1]), __float_as_uint(x1[2]), __float_as_uint(x1[3])) + c1 * v1;
    }
    ushort4 ha, la, hb, lb;
    hl_split(h0, ha, la); hl_split(h1, hb, lb);
    if (D1 == 4) {
      const bf16x8 hv = {(short)ha.x, (short)ha.y, (short)ha.z, (short)ha.w, (short)hb.x, (short)hb.y, (short)hb.z, (short)hb.w};
      const bf16x8 lv = {(short)la.x, (short)la.y, (short)la.z, (short)la.w, (short)lb.x, (short)lb.y, (short)lb.z, (short)lb.w};
      *(bf16x8*)(HI + o) = hv; *(bf16x8*)(LO + o) = lv;
    } else {
      *(ushort4*)(HI + o) = ha; *(ushort4*)(LO + o) = la; *(ushort4*)(HI + o + D1) = hb; *(ushort4*)(LO + o + D1) = lb;
    }
    const f32x4 q = h0 * h0 + h1 * h1;
    row_ss_add(ssout, row, q[0] + q[1] + q[2] + q[3], true);
  }
};
struct EpiDQ {
  static constexpr int BATCH_ROWS = 4;
  static constexpr bool GU = false, PERM = true;
  u16* CB; const float* ssin; float* ssout;
  template <int D1> DI void colpre(int, f32x4&, f32x4&) const {}
  template <int D1> DI void pre(int row, int, float& r, f32x4&, f32x4&) const { r = ssin[row]; }
  template <int D1> DI void op(int row, int col, f32x4 v0, f32x4 v1, float r, f32x4, f32x4, f32x4, f32x4) const {
    r = rsqrtf(r * (1.f / DM) + EPS);
    const bool ok = col < 384;
    v0 *= r; v1 *= r;
    if (ok) { *(ushort4*)(CB + (size_t)row * 384 + col) = pk4(v0); *(ushort4*)(CB + (size_t)row * 384 + col + D1) = pk4(v1); }
    const f32x4 q = v0 * v0 + v1 * v1;
    row_ss_add(ssout, row, ok ? q[0] + q[1] + q[2] + q[3] : 0.f, ok);
  }
};
struct EpiDKV {
  static constexpr int BATCH_ROWS = 4;
  static constexpr bool GU = false, PERM = false;
  u16* CB; const float* ssin; float* ssout; const float* rope; u16* Kf; u16* Km;
  template <int D1> DI void colpre(int, f32x4&, f32x4&) const {}
  template <int D1> DI void pre(int row, int col, float& r, f32x4& x0, f32x4& x1) const {
    r = ssin[row];
    if ((col & ~31) == 256) { const float* rp = rope + (size_t)(row_pos(row) * 16 + (col & 15)) * 2; x0 = *(const f32x4*)rp; x1 = *(const f32x4*)(rp + 4); }
  }
  template <int D1> DI void op(int row, int col, f32x4 v0, f32x4 v1, float r, f32x4 ra, f32x4 rb, f32x4, f32x4) const {
    static_assert(D1 == 16, "rotary pairs are 16 columns apart");
    r = rsqrtf(r * (1.f / DM) + EPS);
    v0 *= r; v1 *= r;
    const bool ok = col < 256;
    if (ok) { *(ushort4*)(CB + (size_t)row * 256 + col) = pk4(v0); *(ushort4*)(CB + (size_t)row * 256 + col + 16) = pk4(v1); }
    const f32x4 q = v0 * v0 + v1 * v1;
    row_ss_add(ssout, row, ok ? q[0] + q[1] + q[2] + q[3] : 0.f, ok);
    if ((col & ~31) == 256) {
      const f32x4 c = {ra[0], ra[2], rb[0], rb[2]}, s = {ra[1], ra[3], rb[1], rb[3]};
      const ushort4 o1 = pk4(v0 * c - v1 * s), o2 = pk4(v1 * c + v0 * s);
      const int i0 = col & 15;
      for (int h = 0; h < 8; ++h) {
        u16* kd = row < MR ? Kf + ((size_t)((row >> 13) * 8 + h) * SEQ + (row & (SEQ - 1))) * 96
                           : Km + (h * 64 + (row - MR)) * 96;
        *(ushort4*)(kd + 64 + i0) = o1; *(ushort4*)(kd + 80 + i0) = o2;
      }
    }
  }
};
struct EpiQ {
  static constexpr int BATCH_ROWS = 4;
  static constexpr bool GU = false, PERM = false;
  u16* Q; const float* rope; const float* ssin; float qs;
  template <int D1> DI void colpre(int, f32x4&, f32x4&) const {}
  template <int D1> DI void pre(int row, int col, float& r, f32x4& x0, f32x4& x1) const {
    r = ssin[row];
    if (((col & ~31) % 96) == 64) { const float* rp = rope + (size_t)(row_pos(row) * 16 + (col & 15)) * 2; x0 = *(const f32x4*)rp; x1 = *(const f32x4*)(rp + 4); }
  }
  template <int D1> DI void op(int row, int col, f32x4 v0, f32x4 v1, float r, f32x4 ra, f32x4 rb, f32x4, f32x4) const {
    static_assert(D1 == 16, "rotary pairs are 16 columns apart");
    r = rsqrtf(r * (1.f / 384.f) + EPS) * qs;
    v0 *= r; v1 *= r;
    if (((col & ~31) % 96) == 64) {
      const f32x4 c = {ra[0], ra[2], rb[0], rb[2]}, s = {ra[1], ra[3], rb[1], rb[3]};
      const f32x4 o1 = v0 * c - v1 * s, o2 = v1 * c + v0 * s;
      v0 = o1; v1 = o2;
    }
    *(ushort4*)(Q + (size_t)row * 768 + col) = pk4(v0);
    *(ushort4*)(Q + (size_t)row * 768 + col + 16) = pk4(v1);
  }
};
struct EpiKV {
  static constexpr int BATCH_ROWS = 4;
  static constexpr bool GU = false, PERM = true;
  u16 *Kf, *Vt, *Km, *Vm; const float* ssin;
  template <int D1> DI void colpre(int, f32x4&, f32x4&) const {}
  template <int D1> DI void pre(int row, int, float& r, f32x4&, f32x4&) const { r = ssin[row]; }
  DI void one(int row, int col, f32x4 v) const {
    if (col < 512) {
      const int h = col >> 6, d = col & 63;
      u16* kd = row < MR ? Kf + ((size_t)((row >> 13) * 8 + h) * SEQ + (row & (SEQ - 1))) * 96 + d
                         : Km + (h * 64 + (row - MR)) * 96 + d;
      *(ushort4*)kd = pk4(v);
    } else {
      const int c = col - 512, h = c >> 6, dv = c & 63;
      u16* vd = row < MR ? Vt + ((size_t)((row >> 13) * 8 + h) * 64 + dv) * SEQ + permt(row & (SEQ - 1))
                         : Vm + (h * 64 + dv) * 64 + permt(row - MR);
      const int st = row < MR ? SEQ : 64;
      vd[0] = f2bf(v[0]); vd[st] = f2bf(v[1]); vd[2 * st] = f2bf(v[2]); vd[3 * st] = f2bf(v[3]);
    }
  }
  template <int D1> DI void op(int row, int col, f32x4 v0, f32x4 v1, float r, f32x4, f32x4, f32x4, f32x4) const {
    r = rsqrtf(r * (1.f / 256.f) + EPS);
    one(row, col, v0 * r); one(row, col + D1, v1 * r);
  }
};

#define LAS __attribute__((address_space(3)))
constexpr int BM = 256, BK = 64, HALF = 128, HTB = HALF * BK * 2, SHM_B = 8 * HTB;
DI int lds_byte(int r, int c) {
  const int st = (r >> 4) * 2 + (c >> 5), rr = r & 15, cc = c & 31, ob = rr * 64 + cc * 2;
  return st * 1024 + (ob ^ (((ob >> 9) & 1) << 5));
}
DI int perm32(int rho) { const int n = rho >> 4, i = rho & 15; return 8 * (i >> 2) + 4 * n + (i & 3); }
DI void stage_rc(int b, int& R, int& C) {
  const int st = b / 1024, sb = b % 1024, swz = sb ^ (((sb >> 9) & 1) << 5);
  R = (st >> 1) * 16 + swz / 64; C = (st & 1) * 32 + (swz % 64) / 2;
}
struct Gemm { const u16* A; const u16* Bt; int lda, ldb, K, nN, a_pn_el, boff; };
DI bool unit_next(int i, int nN, int boff, int& pm, int& pn) {
  const int nM = MR / BM, nwg = nM * nN, G = gridDim.x;
  const long L = (long)i * G + (int)(((unsigned)obid() + (unsigned)boff) % (unsigned)G); if (L >= nwg) return false;
  int wgid = (int)L; { const int q = nwg / 8, r = nwg % 8, xcd = wgid % 8, off = wgid / 8; wgid = (xcd < r ? xcd * (q + 1) : r * (q + 1) + (xcd - r) * q) + off; }
  const int WGM = nN >= 8 ? 4 : 8;
  const int nig = WGM * nN, gid = wgid / nig, fm = gid * WGM, gsz = (nM - fm) < WGM ? (nM - fm) : WGM;
  pm = fm + ((wgid % nig) % gsz); pn = (wgid % nig) / gsz; return true;
}

template <class Epi>
__device__ __forceinline__ void gemm_phase(const Gemm g, const Epi& E) {
  extern __shared__ __attribute__((aligned(16))) unsigned char shm_raw[];
  LAS unsigned char* lds = (LAS unsigned char*)shm_raw;
  const int tid = otid(), wid = __builtin_amdgcn_readfirstlane(tid >> 6), lane = tid & 63, wr = wid >> 2, wc = wid & 3, fr = lane & 15, fq = lane >> 4;
  const int K = g.K, nt = K / BK;
  unsigned voffA[2], voffB[2];
#pragma unroll
  for (int i = 0; i < 2; ++i) { int R, C; stage_rc(tid * 16 + i * 8192, R, C);
    const int Rb = Epi::PERM ? ((R & ~31) + perm32(R & 31)) : R;
    voffA[i] = (unsigned)(R * g.lda + C) * 2u; voffB[i] = (unsigned)(Rb * g.ldb + C) * 2u; }
  const size_t kstep = (size_t)(BK * 2);
  const size_t hstepA = (size_t)HALF * g.lda * 2, hstepB = (size_t)HALF * g.ldb * 2;
  const unsigned ldsw = (unsigned)wid * 1024u;
  const int aoff = lds_byte(wr * 64 + fr, fq * 8), boff = lds_byte(wc * 32 + fr, fq * 8);
#define PG8_SA(b, h) (((b) * 2 + (h)) * HTB)
#define PG8_SB(b, h) ((4 + (b) * 2 + (h)) * HTB)
#define PG8_STAGE(bufoff, gbase, voff) do { _Pragma("unroll") for (int _i = 0; _i < 2; ++_i) \
    __builtin_amdgcn_global_load_lds((const unsigned*)((const char*)(gbase) + (voff)[_i]), (LAS unsigned*)(lds + (bufoff) + ldsw + _i * 8192), 16, 0, 0); } while (0)
#define PG8_LDA(dst, b, h) do { _Pragma("unroll") for (int m = 0; m < 4; ++m) _Pragma("unroll") for (int k = 0; k < 2; ++k) dst[m][k] = *(const LAS bf16x8*)(lds + PG8_SA(b, h) + aoff + m * 2048 + k * 1024); } while (0)
#define PG8_LDB(dst, b, h) do { _Pragma("unroll") for (int n = 0; n < 2; ++n) _Pragma("unroll") for (int k = 0; k < 2; ++k) dst[n][k] = *(const LAS bf16x8*)(lds + PG8_SB(b, h) + boff + n * 2048 + k * 1024); } while (0)
#define PG8_MMA(ai, bj, At_, Bt_) do { __builtin_amdgcn_s_setprio(1); _Pragma("unroll") for (int m = 0; m < 4; ++m) _Pragma("unroll") for (int n = 0; n < 2; ++n) _Pragma("unroll") for (int k = 0; k < 2; ++k) \
    acc[ai][bj][m][n] = __builtin_amdgcn_mfma_f32_16x16x32_bf16(Bt_[n][k], At_[m][k], acc[ai][bj][m][n], 0, 0, 0); __builtin_amdgcn_s_setprio(0); } while (0)
#define PG8_WAIT_V(n) asm volatile("s_waitcnt vmcnt(" #n ")" ::: "memory")
#define PG8_WAIT_L(n) asm volatile("s_waitcnt lgkmcnt(" #n ")" ::: "memory")
#define PG8_BAR __builtin_amdgcn_s_barrier()
#define PG8_SCHED __builtin_amdgcn_sched_barrier(0)
  int cpm, cpn, npm = 0, npn = 0, ui = 0;
  if (!unit_next(0, g.nN, g.boff, cpm, cpn)) return;
  f32x4 acc[2][2][4][2];
#pragma unroll
  for (int a = 0; a < 2; ++a)
#pragma unroll
    for (int b = 0; b < 2; ++b)
#pragma unroll
      for (int m = 0; m < 4; ++m)
#pragma unroll
        for (int n = 0; n < 2; ++n) acc[a][b][m][n] = (f32x4){0.f, 0.f, 0.f, 0.f};
  bf16x8 At[4][2], B0[2][2], B1[2][2];
  const char* cA = (const char*)(g.A + (size_t)cpn * g.a_pn_el) + (size_t)cpm * 2 * hstepA;
  const char* cB = (const char*)g.Bt + (size_t)cpn * 2 * hstepB;
  PG8_STAGE(PG8_SB(0, 0), cB, voffB); PG8_STAGE(PG8_SA(0, 0), cA, voffA); PG8_STAGE(PG8_SB(0, 1), cB + hstepB, voffB); PG8_STAGE(PG8_SA(0, 1), cA + hstepA, voffA);
  if (wr == 1) PG8_BAR;
  PG8_WAIT_V(4); PG8_BAR;
  PG8_STAGE(PG8_SB(1, 0), cB + kstep, voffB); PG8_STAGE(PG8_SA(1, 0), cA + kstep, voffA); PG8_STAGE(PG8_SB(1, 1), cB + hstepB + kstep, voffB);
  PG8_WAIT_V(6); PG8_BAR;
  for (;;) {
    const bool has_next = unit_next(ui + 1, g.nN, g.boff, npm, npn);
    const char* nA = has_next ? (const char*)(g.A + (size_t)npn * g.a_pn_el) + (size_t)npm * 2 * hstepA : cA;
    const char* nB = has_next ? (const char*)g.Bt + (size_t)npn * 2 * hstepB : cB;
#pragma unroll 1
    for (int t = 0; t < nt; t += 2) {
      const bool last = (t == nt - 2);
      const char* a1 = cA + (size_t)(t + 1) * kstep;
      const char* a2 = last ? nA : cA + (size_t)(t + 2) * kstep; const char* b2 = last ? nB : cB + (size_t)(t + 2) * kstep;
      const char* a3 = a2 + kstep; const char* b3 = b2 + kstep;
      PG8_LDB(B0, 0, 0); PG8_SCHED; PG8_LDA(At, 0, 0); PG8_STAGE(PG8_SA(1, 1), a1 + hstepA, voffA);
      PG8_WAIT_L(8); PG8_BAR; PG8_WAIT_L(0); PG8_MMA(0, 0, At, B0); PG8_BAR; PG8_SCHED;
      PG8_LDB(B1, 0, 1); PG8_STAGE(PG8_SB(0, 0), b2, voffB);
      PG8_BAR; PG8_WAIT_L(0); PG8_MMA(0, 1, At, B1); PG8_BAR;
      PG8_LDA(At, 0, 1); PG8_STAGE(PG8_SA(0, 0), a2, voffA);
      PG8_BAR; PG8_WAIT_L(0); PG8_MMA(1, 0, At, B0); PG8_BAR; PG8_SCHED;
      PG8_STAGE(PG8_SB(0, 1), b2 + hstepB, voffB);
      PG8_WAIT_V(6); PG8_BAR; PG8_MMA(1, 1, At, B1); PG8_BAR;
      PG8_LDB(B0, 1, 0); PG8_SCHED; PG8_LDA(At, 1, 0); PG8_STAGE(PG8_SA(0, 1), a2 + hstepA, voffA);
      PG8_WAIT_L(8); PG8_BAR; PG8_WAIT_L(0); PG8_MMA(0, 0, At, B0); PG8_BAR; PG8_SCHED;
      PG8_LDB(B1, 1, 1); PG8_STAGE(PG8_SB(1, 0), b3, voffB);
      PG8_BAR; PG8_WAIT_L(0); PG8_MMA(0, 1, At, B1); PG8_BAR;
      PG8_LDA(At, 1, 1); PG8_STAGE(PG8_SA(1, 0), a3, voffA);
      PG8_BAR; PG8_WAIT_L(0); PG8_MMA(1, 0, At, B0); PG8_BAR; PG8_SCHED;
      PG8_STAGE(PG8_SB(1, 1), b3 + hstepB, voffB);
      PG8_WAIT_V(6); PG8_BAR; PG8_MMA(1, 1, At, B1); PG8_BAR;
    }
    {
      const int t2 = otid(), wid2 = __builtin_amdgcn_readfirstlane(t2 >> 6), wr2 = wid2 >> 2, wc2 = wid2 & 3, fr2 = t2 & 15, fq2 = (t2 & 63) >> 4;
      const int row0 = cpm * BM + wr2 * 64 + fr2;
      const f32x4 z4 = {0.f, 0.f, 0.f, 0.f};
      constexpr int D1 = Epi::PERM ? 4 : 16, FQ = Epi::PERM ? 8 : 4;
      if constexpr (Epi::GU) {
        const int col0 = cpn * HALF + wc2 * 32 + FQ * fq2;
#pragma unroll
        for (int ai = 0; ai < 2; ++ai) {
          float rr[4]; f32x4 xa = z4, xb_ = z4;
#pragma unroll
          for (int m = 0; m < 4; ++m) { rr[m] = 0.f; E.pre(row0 + ai * HALF + m * 16, col0, rr[m], xa, xb_); }
#pragma unroll
          for (int m = 0; m < 4; ++m)
            E.op8(row0 + ai * HALF + m * 16, col0, acc[ai][0][m][0], acc[ai][1][m][0], acc[ai][0][m][1], acc[ai][1][m][1], rr[m]);
        }
      } else {
        const int col0 = cpn * BM + wc2 * 32 + FQ * fq2;
        f32x4 c0[2], c1[2];
#pragma unroll
        for (int bj = 0; bj < 2; ++bj) { c0[bj] = z4; c1[bj] = z4; E.template colpre<D1>(col0 + bj * HALF, c0[bj], c1[bj]); }
        constexpr int BR = Epi::BATCH_ROWS;
#pragma unroll
        for (int am = 0; am < 8 / BR; ++am) {
          const int r0b = am * BR;
          float rr[BR][2]; f32x4 x0[BR][2], x1[BR][2];
#pragma unroll
          for (int m = 0; m < BR; ++m)
#pragma unroll
            for (int bj = 0; bj < 2; ++bj) { const int rs = r0b + m; rr[m][bj] = 0.f; x0[m][bj] = z4; x1[m][bj] = z4;
              E.template pre<D1>(row0 + (rs >> 2) * HALF + (rs & 3) * 16, col0 + bj * HALF, rr[m][bj], x0[m][bj], x1[m][bj]); }
#pragma unroll
          for (int m = 0; m < BR; ++m)
#pragma unroll
            for (int bj = 0; bj < 2; ++bj) { const int rs = r0b + m;
              E.template op<D1>(row0 + (rs >> 2) * HALF + (rs & 3) * 16, col0 + bj * HALF, acc[rs >> 2][bj][rs & 3][0], acc[rs >> 2][bj][rs & 3][1], rr[m][bj], x0[m][bj], x1[m][bj], c0[bj], c1[bj]); }
        }
      }
    }
    if (!has_next) break;
#pragma unroll
    for (int a = 0; a < 2; ++a)
#pragma unroll
      for (int b = 0; b < 2; ++b)
#pragma unroll
        for (int m = 0; m < 4; ++m)
#pragma unroll
          for (int n = 0; n < 2; ++n) acc[a][b][m][n] = (f32x4){0.f, 0.f, 0.f, 0.f};
    cpm = npm; cpn = npn; cA = nA; cB = nB; ++ui;
  }
  PG8_WAIT_V(0);
  if (wr == 0) PG8_BAR;
  PG8_BAR;
#undef PG8_SA
#undef PG8_SB
#undef PG8_STAGE
#undef PG8_LDA
#undef PG8_LDB
#undef PG8_MMA
}

template <class Epi>
__device__ __forceinline__ void skinny(const Gemm g, int nitems, const Epi& E, int first_block = 0) {
  extern __shared__ __attribute__((aligned(16))) float sk_red[];
  const int tid = otid(), wave = __builtin_amdgcn_readfirstlane(tid >> 6), lane = tid & 63, G = gridDim.x;
  const int fr = lane & 15, fq = lane >> 4;
  const int nks = g.K >> 5;
  for (int it = (first_block ? (int)blockIdx.x - first_block + (blockIdx.x < (unsigned)first_block ? (1 << 28) : 0) : G - 1 - (int)blockIdx.x); it < nitems; it += (first_block ? G - first_block : G)) {
    int r0, r1, col, pn;
    if (Epi::GU) { pn = it >> 3; const int w = (it & 7) * 16; r0 = pn * 256 + w; r1 = r0 + 128; col = pn * 128 + w; }
    else { r0 = it * 32; r1 = r0 + 16; col = it * 32; pn = col >> 8; }
    const u16* ap = g.A + (size_t)pn * g.a_pn_el + (size_t)(MR + fr) * g.lda + fq * 8;
    const u16* b0p = g.Bt + (size_t)(r0 + fr) * g.ldb + fq * 8;
    const u16* b1p = g.Bt + (size_t)(r1 + fr) * g.ldb + fq * 8;
    f32x4 a0 = {0.f, 0.f, 0.f, 0.f}, a1 = {0.f, 0.f, 0.f, 0.f};
#pragma unroll 4
    for (int ks = wave; ks < nks; ks += 8) {
      const int k = ks * 32;
      const bf16x8 a = *(const bf16x8*)(ap + k);
      const bf16x8 b0 = *(const bf16x8*)(b0p + k);
      const bf16x8 b1 = *(const bf16x8*)(b1p + k);
      a0 = __builtin_amdgcn_mfma_f32_16x16x32_bf16(b0, a, a0, 0, 0, 0);
      a1 = __builtin_amdgcn_mfma_f32_16x16x32_bf16(b1, a, a1, 0, 0, 0);
    }
    __syncthreads();
    float* my = sk_red + (wave * 64 + lane) * 8;
    *(f32x4*)my = a0; *(f32x4*)(my + 4) = a1;
    __syncthreads();
    if (wave == 0) {
      f32x4 s0 = {0.f, 0.f, 0.f, 0.f}, s1 = {0.f, 0.f, 0.f, 0.f};
#pragma unroll
      for (int w = 0; w < 8; ++w) { s0 += *(const f32x4*)(sk_red + (w * 64 + lane) * 8); s1 += *(const f32x4*)(sk_red + (w * 64 + lane) * 8 + 4); }
      float r = 0.f; f32x4 x0 = {0.f, 0.f, 0.f, 0.f}, x1 = x0, c0 = x0, c1 = x0;
      if constexpr (Epi::GU) { E.pre(MR + fr, col + 4 * fq, r, x0, x1); E.op(MR + fr, col + 4 * fq, s0, s1, r); }
      else {
        E.template colpre<16>(col + 4 * fq, c0, c1);
        E.template pre<16>(MR + fr, col + 4 * fq, r, x0, x1);
        E.template op<16>(MR + fr, col + 4 * fq, s0, s1, r, x0, x1, c0, c1);
      }
    }
  }
  __syncthreads();
}
template <class Epi>
__device__ __forceinline__ void gemm_all(const Gemm g, int n_skinny, const Epi& E, int first_block = 0) {
  gemm_phase<Epi>(g, E);
  skinny<Epi>(g, n_skinny, E, first_block);
}

__device__ __forceinline__ void conv_tile(const float* __restrict__ src, int sld, int c0, int cvalid_end, int k0, int kend,
                          u16* __restrict__ dst, int dld, int r0, const float* __restrict__ gain) {
  extern __shared__ __attribute__((aligned(16))) float ctile[];
  const int tid = otid();
  __syncthreads();
  {
    const int j = tid & 63, i0 = tid >> 6;
    const bool cok = c0 + j < cvalid_end;
    float v[32];
#pragma unroll
    for (int e = 0; e < 32; ++e) {
      const int k = k0 + i0 + e * 8;
      v[e] = (cok && k < kend) ? src[(size_t)k * sld + c0 + j] : 0.f;
    }
    if (gain) {
#pragma unroll
      for (int e = 0; e < 32; ++e) { const int k = k0 + i0 + e * 8; v[e] *= (k < kend) ? gain[k] : 0.f; }
    }
#pragma unroll
    for (int e = 0; e < 32; ++e) ctile[(i0 + e * 8) * 65 + j] = v[e];
  }
  __syncthreads();
  {
    const int j = tid >> 3, ic = tid & 7;
#pragma unroll
    for (int q = 0; q < 4; ++q) {
      const int kk = (q * 8 + ic) * 8;
      if (k0 + kk < kend) {
        bf16x8 v;
#pragma unroll
        for (int e = 0; e < 8; ++e) v[e] = (short)f2bf(ctile[(kk + e) * 65 + j]);
        *(bf16x8*)(dst + (size_t)(r0 + j) * dld + k0 + kk) = v;
      }
    }
  }
}
__device__ __forceinline__ void conv_seg(const float* src, int sld, int c0, int ncols_valid, int ncols_pad, int K, u16* dst, int dld, int r0, const float* gain) {
  const int nct = ncols_pad / 64, nkt = (K + 255) / 256;
  for (int t = blockIdx.x; t < nct * nkt; t += gridDim.x) {
    const int ct = t % nct, kt = t / nct;
    conv_tile(src, sld, c0 + ct * 64, c0 + ncols_valid, kt * 256, K, dst, dld, r0 + ct * 64, gain);
  }
}

__device__ __forceinline__ void conv_ffn(PP p, int f, int t0, int stride, int tbeg = 0, int tend = 528) {
  unsigned char* ws = p->ws;
  const int l = f >> 1, s2 = f & 1;
  for (int t = tbeg + t0; t < tend; t += stride) {
    if (t < 352) {
      const int which = t & 1, n64 = (t >> 1) % 44, kt = (t >> 1) / 44;
      const float* src = p->in[(s2 ? 8 : 3) + which] + (size_t)l * 1024 * DFF;
      u16* dst = (u16*)(ws + WS_WGU + (size_t)f * WGU_ONE);
      conv_tile(src, DFF, n64 * 64, DFF, kt * 256, 1024, dst, 1024, (n64 >> 1) * 256 + which * 128 + (n64 & 1) * 64, p->in[s2 ? 7 : 2] + l * DM);
    } else {
      const int r = t - 352, ct = r % 16, kt = r / 16;
      const float* src = p->in[s2 ? 10 : 5] + (size_t)l * DFF * 1024;
      u16* dst = (u16*)(ws + WS_WD + (size_t)f * WD_ONE);
      conv_tile(src, 1024, ct * 64, 1024, kt * 256, DFF, dst, DFF, ct * 64, nullptr);
    }
  }
  __syncthreads();
}
__device__ __forceinline__ void conv_small(PP p) {
  unsigned char* ws = p->ws;
  for (int t = blockIdx.x; t < 256; t += gridDim.x) {
    const float* src; const float* gain = nullptr; u16* dst; int sld, c0, cend, k0, kend, dld, r0;
    if (t < 32) {
      const int i = t >> 2, ct = t & 3;
      src = p->in[11] + (size_t)i * 65536; sld = 256; c0 = ct * 64; cend = 256; k0 = 0; kend = 256;
      dst = (u16*)(ws + WS_WPOOL) + (size_t)i * 65536; dld = 256; r0 = ct * 64;
    } else if (t < 64) {
      const int r = t - 32, ct = r & 7, kt = r >> 3;
      src = p->in[14]; sld = 288; c0 = ct * 64; cend = 288; k0 = kt * 256; kend = 1024;
      dst = (u16*)(ws + WS_WDKV); dld = 1024; r0 = ct * 64; gain = p->in[13];
    } else if (t < 80) {
      const int r = t - 64, which = r >> 3, ct = r & 7;
      src = p->in[16 + which]; sld = 512; c0 = ct * 64; cend = 512; k0 = 0; kend = 256;
      dst = (u16*)(ws + WS_WUKV); dld = 256; r0 = which * 512 + ct * 64; gain = p->in[15];
    } else {
      const int r = (t - 80) % 88, j = (t - 80) / 88;
      if (r < 32) {
        const int ct = r & 7, kt = r >> 3;
        src = p->in[18] + (size_t)j * 1024 * 384; sld = 384; c0 = ct * 64; cend = 384; k0 = kt * 256; kend = 1024;
        dst = (u16*)(ws + WS_WDQ) + (size_t)j * 512 * 1024; dld = 1024; r0 = ct * 64; gain = p->in[6] + (2 + j) * DM;
      } else if (r < 56) {
        const int q = r - 32, ct = q % 12, kt = q / 12;
        src = p->in[20] + (size_t)j * 384 * 768; sld = 768; c0 = ct * 64; cend = 768; k0 = kt * 256; kend = 384;
        dst = (u16*)(ws + WS_WUQ) + (size_t)j * 768 * 384; dld = 384; r0 = ct * 64; gain = p->in[19] + j * 384;
      } else {
        const int q = r - 56, ct = q & 15, kt = q >> 4;
        src = p->in[21] + (size_t)j * 512 * 1024; sld = 1024; c0 = ct * 64; cend = 1024; k0 = kt * 256; kend = 512;
        dst = (u16*)(ws + WS_WO) + (size_t)j * 1024 * 512; dld = 512; r0 = ct * 64;
      }
    }
    conv_tile(src, sld, c0, cend, k0, kend, dst, dld, r0, gain);
  }
  __syncthreads();
}

template <int MODE>
__device__ __forceinline__ void norm_rows(PP p, const float* __restrict__ gain) {
  const int tid = otid(), wave = tid >> 6, lane = tid & 63;
  u16* HI = (u16*)(p->ws + WS_XN); u16* LO = (u16*)(p->ws + WS_LO);
  float* ss0 = (float*)(p->ws + WS_SS);
  const int nrows = (MODE == 2) ? MR : MALL;
  constexpr int NB = 4;
  const int stride = gridDim.x * 8;
  for (int row0 = blockIdx.x * 8 + wave; row0 < nrows; row0 += NB * stride) {
    f32x4 v[NB][4];
#pragma unroll
    for (int k = 0; k < NB; ++k) {
      const int row = row0 + k * stride;
      if (row < nrows) {
        if (MODE == 1) {
          const float* src = row < MR ? p->in[0] + (size_t)row * DM : p->in[1] + (size_t)(row - MR) * DM;
#pragma unroll
          for (int i = 0; i < 4; ++i) v[k][i] = ((const f32x4*)src)[i * 64 + lane];
        } else {
#pragma unroll
          for (int i = 0; i < 4; ++i) {
            const uint2 a = ((const uint2*)(HI + (size_t)row * DM))[i * 64 + lane], b = ((const uint2*)(LO + (size_t)row * DM))[i * 64 + lane];
            v[k][i] = hl_sum(a.x, a.y, b.x, b.y);
          }
        }
      } else {
#pragma unroll
        for (int i = 0; i < 4; ++i) v[k][i] = (f32x4){0.f, 0.f, 0.f, 0.f};
      }
    }
#pragma unroll
    for (int k = 0; k < NB; ++k) {
      const int row = row0 + k * stride;
      float ss = 0.f;
#pragma unroll
      for (int i = 0; i < 4; ++i) { const f32x4 q = v[k][i] * v[k][i]; ss += q[0] + q[1] + q[2] + q[3]; }
      ss = wave_sum(ss);
      if (row < nrows) {
        if (MODE == 1) {
          if (lane == 0) ss0[row] = ss;
#pragma unroll
          for (int i = 0; i < 4; ++i) {
            ushort4 hi, lo; hl_split(v[k][i], hi, lo);
            ((ushort4*)(HI + (size_t)row * DM))[i * 64 + lane] = hi;
            ((ushort4*)(LO + (size_t)row * DM))[i * 64 + lane] = lo;
          }
        } else {
          const float r = rsqrtf(ss * (1.f / DM) + EPS);
#pragma unroll
          for (int i = 0; i < 4; ++i) {
            const f32x4 g = ((const f32x4*)gain)[i * 64 + lane];
            ((f32x4*)(p->out + (size_t)row * DM))[i * 64 + lane] = v[k][i] * g * r;
          }
        }
      }
    }
  }
}

template <int W>
__device__ __forceinline__ void pool_seg(const u16* __restrict__ HB, const float* __restrict__ ss, const float* __restrict__ gain,
                                         u16* __restrict__ P, int b, int t0, int c8) {
  constexpr int NR = W - 1 + 8;
  bf16x8 v[NR]; float rr[NR];
#pragma unroll
  for (int j = 0; j < NR; ++j) {
    const int q = NMETA + t0 - (W - 1) + j;
    const int r = q >= NMETA ? b * SEQ + q - NMETA : MR + q;
    v[j] = *(const bf16x8*)(HB + (size_t)r * DM + c8 * 8);
    rr[j] = ss[r];
  }
  const f32x4 g0 = *(const f32x4*)(gain + c8 * 8), g1 = *(const f32x4*)(gain + c8 * 8 + 4);
  float S[8];
#pragma unroll
  for (int e = 0; e < 8; ++e) S[e] = 0.f;
#pragma unroll
  for (int j = 0; j < NR; ++j) {
    const float rj = rsqrtf(rr[j] * (1.f / DM) + EPS);
    float u[8];
#pragma unroll
    for (int e = 0; e < 8; ++e) { u[e] = bf2f((u16)v[j][e]) * rj; S[e] += u[e]; }
    if (j >= W - 1) {
      bf16x8 o;
#pragma unroll
      for (int e = 0; e < 8; ++e) o[e] = (short)f2bf((S[e] * (1.f / W) - u[e]) * (e < 4 ? g0[e & 3] : g1[e & 3]));
      *(bf16x8*)(P + (size_t)(b * SEQ + t0 + j - (W - 1)) * DM + c8 * 8) = o;
      const float ro = rsqrtf(rr[j - (W - 1)] * (1.f / DM) + EPS);
#pragma unroll
      for (int e = 0; e < 8; ++e) S[e] -= bf2f((u16)v[j - (W - 1)][e]) * ro;
    }
  }
}
__device__ __forceinline__ void pool_phase(const u16* __restrict__ HB, const float* __restrict__ ss, const float* __restrict__ gain, u16* __restrict__ P) {
  const int nitem = 4 * 2048 * 32;
  for (int i = blockIdx.x * NTHR + otid(); i < nitem; i += gridDim.x * NTHR) {
    const int c = i & 31, bseg = (i >> 5) & 2047, g = i >> 16;
    const int b = bseg >> 10, t0 = (bseg & 1023) * 8, c8 = g * 32 + c;
    if (g == 0) pool_seg<2>(HB, ss, gain, P, b, t0, c8);
    else if (g == 1) pool_seg<4>(HB, ss, gain, P, b, t0, c8);
    else if (g == 2) pool_seg<8>(HB, ss, gain, P, b, t0, c8);
    else pool_seg<16>(HB, ss, gain, P, b, t0, c8);
  }
  for (int idx = blockIdx.x * NTHR + otid(); idx < NMETA * 128; idx += gridDim.x * NTHR) {
    const int pos = idx >> 7, c8 = idx & 127, w = 2 << (c8 >> 5);
    const int cnt = min(w, pos + 1);
    float acc[8], self[8];
#pragma unroll
    for (int e = 0; e < 8; ++e) { acc[e] = 0.f; self[e] = 0.f; }
    bf16x8 v[16]; float rr[16];
#pragma unroll
    for (int j = 0; j < 16; ++j) {
      v[j] = (bf16x8){0, 0, 0, 0, 0, 0, 0, 0}; rr[j] = 1.f;
      if (j < cnt) { const int r = MR + pos - j; v[j] = *(const bf16x8*)(HB + (size_t)r * DM + c8 * 8); rr[j] = ss[r]; }
    }
#pragma unroll
    for (int j = 0; j < 16; ++j) {
      const float rj = (j < cnt) ? rsqrtf(rr[j] * (1.f / DM) + EPS) : 0.f;
#pragma unroll
      for (int e = 0; e < 8; ++e) { const float f = bf2f((u16)v[j][e]) * rj; acc[e] += f; if (j == 0) self[e] = f; }
    }
    const float inv = 1.f / (float)cnt;
    const f32x4 g0 = *(const f32x4*)(gain + c8 * 8), g1 = *(const f32x4*)(gain + c8 * 8 + 4);
    bf16x8 o;
#pragma unroll
    for (int e = 0; e < 8; ++e) o[e] = (short)f2bf((acc[e] * inv - self[e]) * (e < 4 ? g0[e & 3] : g1[e & 3]));
    *(bf16x8*)(P + (size_t)(MR + pos) * DM + c8 * 8) = o;
  }
}

constexpr int KPITCH = 208, VPITCH = 144, KBYTES = 64 * KPITCH, ABUF = KBYTES + 64 * VPITCH;
__device__ __forceinline__ void attn_block(PP p, int b, int h, int qb) {
  extern __shared__ __attribute__((aligned(16))) unsigned char alds[];
  const int tid = otid(), wave = tid >> 6, lane = tid & 63, l32 = lane & 31, hl = lane >> 5;
  const u16* Q = (const u16*)(p->ws + WS_G + GA_Q);
  u16* O = (u16*)(p->ws + WS_G + GA_O);
  const bool meta = qb < 0;
  int qrow, cw, cmax;
  if (!meta) { qrow = b * SEQ + qb * 256 + wave * 32 + l32; cw = qb * 4 + (wave >> 1); cmax = qb * 4 + 3; }
  else { qrow = MR + min(l32, 15); cw = (wave == 0) ? -1 : -2; cmax = -1; }
  bf16x8 qf[6];
  {
    const u16* qp = Q + (size_t)qrow * 768 + h * 96 + hl * 8;
#pragma unroll
    for (int ks = 0; ks < 6; ++ks) qf[ks] = *(const bf16x8*)(qp + ks * 16);
  }
  f32x16 o0, o1;
#pragma unroll
  for (int i = 0; i < 16; ++i) { o0[i] = 0.f; o1[i] = 0.f; }
  float mrun = -1e30f, lsum = 0.f;
  const u16* Kg = (const u16*)p->out + (size_t)((b * 8 + h) * SEQ) * 96;
  const u16* Vg = (const u16*)p->out + KF_ELEMS + (size_t)((b * 8 + h) * 64) * SEQ;
  const u16* Kmg = (const u16*)(p->ws + WS_KM) + h * 64 * 96;
  const u16* Vmg = (const u16*)(p->ws + WS_VM) + h * 64 * 64;
  const int vdv = tid >> 3, vpart = tid & 7;
  const int kw0 = (tid / 12) * KPITCH + (tid % 12) * 16;
  const int kw1 = ((tid + 512) / 12) * KPITCH + ((tid + 512) % 12) * 16;
  const int vw = KBYTES + vdv * VPITCH + vpart * 16;
  uint4 kr0, kr1 = make_uint4(0, 0, 0, 0), vr;
#define ATT_LOAD(kt) do { const uint4* ks_ = (const uint4*)((kt) < 0 ? Kmg : Kg + (size_t)(kt) * 64 * 96); \
    kr0 = ks_[tid]; if (tid < 256) kr1 = ks_[tid + 512]; \
    vr = *(const uint4*)((kt) < 0 ? Vmg + vdv * 64 + vpart * 8 : Vg + (size_t)vdv * SEQ + (kt) * 64 + vpart * 8); } while (0)
#define ATT_WRITE(buf) do { unsigned char* b_ = alds + (buf) * ABUF; *(uint4*)(b_ + kw0) = kr0; if (tid < 256) *(uint4*)(b_ + kw1) = kr1; \
    *(uint4*)(b_ + vw) = vr; } while (0)
  ATT_LOAD(-1);
  ATT_WRITE(0);
  __syncthreads();
  int it = 0;
  for (int kt = -1; kt <= cmax; ++kt, ++it) {
    const int buf = it & 1;
    if (kt < cmax) ATT_LOAD(kt + 1);
    if (kt <= cw) {
      const unsigned char* kb = alds + buf * ABUF;
      const unsigned char* vb = kb + KBYTES;
      f32x16 s0, s1;
#pragma unroll
      for (int i = 0; i < 16; ++i) { s0[i] = 0.f; s1[i] = 0.f; }
#pragma unroll
      for (int ks = 0; ks < 6; ++ks) {
        const bf16x8 k0 = *(const bf16x8*)(kb + l32 * KPITCH + ks * 32 + hl * 16);
        const bf16x8 k1 = *(const bf16x8*)(kb + (32 + l32) * KPITCH + ks * 32 + hl * 16);
        s0 = __builtin_amdgcn_mfma_f32_32x32x16_bf16(k0, qf[ks], s0, 0, 0, 0);
        s1 = __builtin_amdgcn_mfma_f32_32x32x16_bf16(k1, qf[ks], s1, 0, 0, 0);
      }
      if (kt < 0) {
#pragma unroll
        for (int i = 8; i < 16; ++i) s0[i] = -1e30f;
#pragma unroll
        for (int i = 0; i < 16; ++i) s1[i] = -1e30f;
      }
      float mx = s0[0];
#pragma unroll
      for (int i = 1; i < 16; ++i) mx = fmaxf(mx, s0[i]);
#pragma unroll
      for (int i = 0; i < 16; ++i) mx = fmaxf(mx, s1[i]);
      mx = xhalf_max(mx);
      const float mnew = fmaxf(mrun, mx);
      const float alpha = __builtin_amdgcn_exp2f(mrun - mnew);
      mrun = mnew;
      float ps = 0.f;
#pragma unroll
      for (int i = 0; i < 16; ++i) { s0[i] = __builtin_amdgcn_exp2f(s0[i] - mnew); ps += s0[i]; }
#pragma unroll
      for (int i = 0; i < 16; ++i) { s1[i] = __builtin_amdgcn_exp2f(s1[i] - mnew); ps += s1[i]; }
      lsum = lsum * alpha + ps;
#pragma unroll
      for (int i = 0; i < 16; ++i) { o0[i] *= alpha; o1[i] *= alpha; }
#pragma unroll
      for (int jp = 0; jp < 4; ++jp) {
        bf16x8 pf;
#pragma unroll
        for (int e = 0; e < 8; ++e) pf[e] = (short)f2bf((jp < 2) ? s0[(jp & 1) * 8 + e] : s1[(jp & 1) * 8 + e]);
        const bf16x8 v0 = *(const bf16x8*)(vb + l32 * VPITCH + (jp * 16 + hl * 8) * 2);
        const bf16x8 v1 = *(const bf16x8*)(vb + (32 + l32) * VPITCH + (jp * 16 + hl * 8) * 2);
        o0 = __builtin_amdgcn_mfma_f32_32x32x16_bf16(v0, pf, o0, 0, 0, 0);
        o1 = __builtin_amdgcn_mfma_f32_32x32x16_bf16(v1, pf, o1, 0, 0, 0);
        }
    }
    if (kt < cmax) ATT_WRITE(buf ^ 1);
    __syncthreads();
  }
#undef ATT_LOAD
#undef ATT_WRITE
  const float ltot = xhalf_sum(lsum);
  if (cw >= -1 && (!meta || l32 < 16)) {
    const float inv = 1.f / ltot;
    u16* op = O + (size_t)qrow * 512 + h * 64 + 4 * hl;
#pragma unroll
    for (int g4 = 0; g4 < 4; ++g4) {
      ushort4 a, c;
      a.x = f2bf(o0[g4 * 4 + 0] * inv); a.y = f2bf(o0[g4 * 4 + 1] * inv); a.z = f2bf(o0[g4 * 4 + 2] * inv); a.w = f2bf(o0[g4 * 4 + 3] * inv);
      c.x = f2bf(o1[g4 * 4 + 0] * inv); c.y = f2bf(o1[g4 * 4 + 1] * inv); c.z = f2bf(o1[g4 * 4 + 2] * inv); c.w = f2bf(o1[g4 * 4 + 3] * inv);
      *(ushort4*)(op + 8 * g4) = a;
      *(ushort4*)(op + 32 + 8 * g4) = c;
    }
  }
}

__device__ __forceinline__ void attn_phase(PP p) {
  const int G = gridDim.x;
  for (int it = blockIdx.x; it < 256; it += G) {
    const int nsub = it < 256 ? 2 : 1;
    for (int sub = 0; sub < nsub; ++sub) {
      int b, h, qb;
      if (it < 256) { const int bh = it >> 4, i = it & 15; b = bh >> 3; h = bh & 7; qb = sub ? i : 31 - i; }
      else { b = 0; h = it - 256; qb = -1; }
      attn_block(p, b, h, qb);
    }
  }
}

__device__ __forceinline__ void misc_init(PP p) {
  float2* rope = (float2*)(p->ws + WS_ROPE);
  for (int idx = blockIdx.x * NTHR + otid(); idx < 8208 * 16; idx += gridDim.x * NTHR) {
    const int pos = idx >> 4, i = idx & 15;
    const float inv = 1.0f / powf(10000.f, (float)(2 * i) / 32.f);
    const float ang = (float)pos * inv;
    float s, c; sincosf(ang, &s, &c);
    rope[idx] = make_float2(c, s);
  }
  unsigned* z = (unsigned*)(p->ws + WS_KM);
  const int nz = (int)((WS_HM - WS_KM) / 4);
  for (int idx = blockIdx.x * NTHR + otid(); idx < nz; idx += gridDim.x * NTHR) z[idx] = 0u;
  unsigned* zs = (unsigned*)(p->ws + WS_SS) + SSLD;
  for (int idx = blockIdx.x * NTHR + otid(); idx < (NSLOT - 1) * SSLD; idx += gridDim.x * NTHR) zs[idx] = 0u;
}

#define XB_TMO      128
#define XB_XCNT(j)  (256  + 64 * (j))
#define XB_XSUB(j)  (1280 + 64 * (j))
#define XB_XGEN(j)  (2304 + 64 * (j))
#define XB_TOP      3328
#define XB_TOPGEN   3392
#define XCD_BAR_WORDS 3456
#define XB_SPIN_CAP (1u << 20)
DI unsigned xb_ld(unsigned* p)              { return __hip_atomic_load(p, __ATOMIC_RELAXED, __HIP_MEMORY_SCOPE_AGENT); }
DI unsigned xb_add(unsigned* p, unsigned v) { return __hip_atomic_fetch_add(p, v, __ATOMIC_RELAXED, __HIP_MEMORY_SCOPE_AGENT); }
DI unsigned xb_xcc_id() { return (unsigned)__builtin_amdgcn_s_getreg((3 << 11) | 20) & 0xFu; }
#define XB_SPIN(cond, bar) do { unsigned _sp = 0; while (cond) { __builtin_amdgcn_s_sleep(1); \
    if ((++_sp & 255u) == 0u) { if (xb_ld(&(bar)[XB_TMO])) break; if (_sp > XB_SPIN_CAP) { atomicAdd(&(bar)[XB_TMO], 1u); break; } } } } while (0)
struct XcdBarrier { unsigned* bar; unsigned x; volatile LAS unsigned* st; };
DI XcdBarrier xcd_barrier_post(unsigned* bar, volatile LAS unsigned* st) {
  XcdBarrier b; b.bar = bar; b.x = xb_xcc_id(); b.st = st;
  if (threadIdx.x == 0) (void)xb_add(&bar[XB_XCNT(b.x)], 1u);
  return b;
}
DI void xcd_barrier_complete(unsigned* bar, unsigned x, unsigned& nloc, unsigned& nx) {
  const unsigned G = gridDim.x * gridDim.y * gridDim.z;
  unsigned sum, cnt, mine, sp = 0u;
  for (;;) {
    sum = 0u; cnt = 0u; mine = 0u;
#pragma unroll
    for (unsigned j = 0; j < 16; ++j) { const unsigned c = xb_ld(&bar[XB_XCNT(j)]); sum += c; cnt += (c > 0u) ? 1u : 0u; mine = (j == x) ? c : mine; }
    if (sum == G) break;
    __builtin_amdgcn_s_sleep(1);
    if ((++sp & 255u) == 0u) { if (xb_ld(&bar[XB_TMO])) break; if (sp > XB_SPIN_CAP) { atomicAdd(&bar[XB_TMO], 1u); break; } }
  }
  nloc = mine > 0u ? mine : 1u; nx = cnt > 0u ? cnt : 1u;
}
DI void xcd_barrier(const XcdBarrier& b) {
  asm volatile("s_waitcnt vmcnt(0)" ::: "memory");
  __syncthreads();
  if (threadIdx.x == 0) {
    unsigned* bar = b.bar;
    unsigned bx = __builtin_amdgcn_readfirstlane(b.x); asm volatile("" : "+s"(bx));
    __builtin_amdgcn_s_waitcnt(0);
    unsigned nloc = b.st[0], nx = b.st[1];
    if (nloc == 0u) { xcd_barrier_complete(bar, bx, nloc, nx); b.st[0] = nloc; b.st[1] = nx; }
    const unsigned old = xb_add(&bar[XB_XSUB(bx)], 1u);
    const unsigned gen = old / nloc;
    if (old + 1u == (gen + 1u) * nloc) {
      __builtin_amdgcn_fence(__ATOMIC_RELEASE, "agent");
      asm volatile("s_waitcnt vmcnt(0)" ::: "memory");
      const unsigned og = xb_add(&bar[XB_TOP], 1u);
      const unsigned tg = og / nx;
      if (og + 1u == (tg + 1u) * nx) xb_add(&bar[XB_TOPGEN], 1u);
      else XB_SPIN(xb_ld(&bar[XB_TOPGEN]) == tg, bar);
      __builtin_amdgcn_fence(__ATOMIC_ACQUIRE, "agent");
      xb_add(&bar[XB_XGEN(bx)], 1u);
      asm volatile("s_waitcnt vmcnt(0)" ::: "memory");
    } else {
      XB_SPIN(xb_ld(&bar[XB_XGEN(bx)]) == gen, bar);
      __builtin_amdgcn_fence(__ATOMIC_ACQUIRE, "agent");
      asm volatile("s_waitcnt vmcnt(0)" ::: "memory");
    }
  }
  __syncthreads();
}

#define GSYNC() do { xcd_barrier(xb); p = launder(p); } while (0)
__device__ __forceinline__ void ffn(PP p, int f, int sin, int sout, const XcdBarrier& xb, bool with_kv, bool meta) {
  if (with_kv) {
    unsigned char* ws = p->ws; float* SS = (float*)(ws + WS_SS);
    EpiDKV E{(u16*)(ws + WS_CKV), SS + (size_t)sin * SSLD, SS + (size_t)SLOT_KV * SSLD, (const float*)(ws + WS_ROPE), (u16*)p->out, (u16*)(ws + WS_KM)};
    gemm_all<EpiDKV>(Gemm{(const u16*)(ws + WS_XN), (const u16*)(ws + WS_WDKV), 1024, 1024, 1024, 2, 0, 128}, 9, E);
  }
  {
    unsigned char* ws = p->ws;
    EpiSwiglu E{(u16*)(ws + WS_G), (const float*)(ws + WS_SS) + (size_t)sin * SSLD};
    gemm_all<EpiSwiglu>(Gemm{(const u16*)(ws + WS_XN), (const u16*)(ws + WS_WGU + (size_t)f * WGU_ONE), 1024, 1024, 1024, 22, 0, 0}, meta ? DFF / 16 : 0, E, ogdim() == 256 ? 128 : 0);
    if (f < 7) { const int gd = ogdim(), bid = obid();
      if (gd == 256) { if (bid >= 128) { if (f == 0) conv_ffn(p, 0, bid - 128, 128, 352, 528); conv_ffn(p, f + 1, bid - 128, 128); } }
      else { if (f == 0) conv_ffn(p, 0, bid, gd, 352, 528); conv_ffn(p, f + 1, bid, gd); } }
    if (DUP_GU) { xcd_barrier(xb); gemm_phase<EpiSwiglu>(Gemm{(const u16*)(ws + WS_XN), (const u16*)(ws + WS_WGU + (size_t)f * WGU_ONE), 1024, 1024, 1024, 22, 0, 0}, E); }
    if (DUP_SKINNY) { xcd_barrier(xb); skinny<EpiSwiglu>(Gemm{(const u16*)(ws + WS_XN), (const u16*)(ws + WS_WGU + (size_t)f * WGU_ONE), 1024, 1024, 1024, 22, 0, 0}, DFF / 16, E); }
  }
  GSYNC();
  {
    unsigned char* ws = p->ws;
    EpiResidT<false> E{(u16*)(ws + WS_XN), (u16*)(ws + WS_LO), (float*)(ws + WS_SS) + (size_t)sout * SSLD, nullptr, 0.5f};
    gemm_all<EpiResidT<false>>(Gemm{(const u16*)(ws + WS_G), (const u16*)(ws + WS_WD + (size_t)f * WD_ONE), DFF, DFF, DFF, 4, 0, 0}, meta ? 1024 / 32 : 0, E);
  }
  if (with_kv) {
    unsigned char* ws = p->ws; float* SS = (float*)(ws + WS_SS);
    EpiKV E{(u16*)p->out, (u16*)p->out + KF_ELEMS, (u16*)(ws + WS_KM), (u16*)(ws + WS_VM), SS + (size_t)SLOT_KV * SSLD};
    gemm_all<EpiKV>(Gemm{(const u16*)(ws + WS_CKV), (const u16*)(ws + WS_WUKV), 256, 256, 256, 4, 0, 0}, 32, E);
  }
  GSYNC();
}

__global__ void __launch_bounds__(NTHR, 2) mega(Params p_unused) {
  extern __shared__ __attribute__((aligned(16))) unsigned char shm_top[];
  cg::grid_group grid = cg::this_grid();
  PP p = launder((PP)__builtin_amdgcn_kernarg_segment_ptr());

  if (threadIdx.x < 4) ((volatile LAS unsigned*)((LAS unsigned char*)shm_top + SHM_B))[threadIdx.x] = 0u;
  if (gridDim.x == 0x7fffffffu) grid.sync();
  conv_ffn(p, 0, blockIdx.x, gridDim.x, 0, 352);
  conv_small(p);
  misc_init(p);
  norm_rows<1>(p, nullptr);
  p = launder(p);
  const XcdBarrier xb = xcd_barrier_post((unsigned*)(p->ws + WS_BAR), (volatile LAS unsigned*)((LAS unsigned char*)shm_top + SHM_B));
  GSYNC();

  for (int l = 0; l < DEPTH; ++l) {
    ffn(p, l * 2, 3 * l, 3 * l + 1, xb, l == 2, l < 2);
    unsigned char* ws = p->ws;
    float* SS = (float*)(ws + WS_SS);
    u16* HB = (u16*)(ws + WS_XN);
    float* Hm = (float*)(ws + WS_HM);
    if (l < 2) {
      u16* P = (u16*)(ws + WS_G + GA_P);
      pool_phase(HB, SS + (size_t)(3 * l + 1) * SSLD, p->in[6] + l * DM, P);
      GSYNC();
      ws = p->ws; SS = (float*)(ws + WS_SS); HB = (u16*)(ws + WS_XN); Hm = (float*)(ws + WS_HM); P = (u16*)(ws + WS_G + GA_P);
      {
        EpiResidT<true> E{HB, (u16*)(ws + WS_LO), SS + (size_t)(3 * l + 2) * SSLD, p->in[12] + l * DM, 1.f};
        gemm_all<EpiResidT<true>>(Gemm{P, (const u16*)(ws + WS_WPOOL) + (size_t)l * 4 * 65536, 1024, 256, 256, 4, 256, 0}, 32, E);
      }
      GSYNC();
    } else {
      const int j = l - 2;
      {
        EpiDQ E{(u16*)(ws + WS_G + GA_CQN), SS + (size_t)(3 * l + 1) * SSLD, SS + (size_t)(SLOT_Q + j) * SSLD};
        gemm_all<EpiDQ>(Gemm{HB, (const u16*)(ws + WS_WDQ) + (size_t)j * 512 * 1024, 1024, 1024, 1024, 2, 0, 0}, 0, E);
      }
      GSYNC();
      ws = p->ws; SS = (float*)(ws + WS_SS);
      {
        EpiQ E{(u16*)(ws + WS_G + GA_Q), (const float*)(ws + WS_ROPE), SS + (size_t)(SLOT_Q + j) * SSLD, 0.10206207261596577f * 1.4426950408889634f};
        gemm_all<EpiQ>(Gemm{(const u16*)(ws + WS_G + GA_CQN), (const u16*)(ws + WS_WUQ) + (size_t)j * 768 * 384, 384, 384, 384, 3, 0, 0}, 0, E);
      }
      GSYNC();
      attn_phase(p);
      if (DUP_ATTN) { GSYNC(); attn_phase(p); }
      GSYNC();
      ws = p->ws; SS = (float*)(ws + WS_SS); HB = (u16*)(ws + WS_XN); Hm = (float*)(ws + WS_HM);
      {
        EpiResidT<false> E{HB, (u16*)(ws + WS_LO), SS + (size_t)(3 * l + 2) * SSLD, nullptr, 1.f};
        gemm_all<EpiResidT<false>>(Gemm{(const u16*)(ws + WS_G + GA_O), (const u16*)(ws + WS_WO) + (size_t)j * 1024 * 512, 512, 512, 512, 4, 0, 0}, 0, E);
      }
      GSYNC();
    }
    ffn(p, l * 2 + 1, 3 * l + 2, 3 * l + 3, xb, false, l < 2);
  }
  norm_rows<2>(p, p->in[22]);
}

extern "C" void kernel_launch(void* const* d_in, const int* in_sizes, int n_in, void* d_out, int out_size,
                              void* d_ws, size_t ws_size, hipStream_t stream) {
  static int grid_blocks = 0;
  if (grid_blocks == 0) {
    if (n_in != 23 || out_size != MR * DM || ws_size < WS_END) {
      fprintf(stderr, "kernel_launch: unexpected problem (n_in %d out %d ws %zu need %zu)\n", n_in, out_size, ws_size, (size_t)WS_END);
      grid_blocks = -1; return;
    }
    int dev = 0, cus = 0, per_cu = 0;
    hipGetDevice(&dev);
    hipDeviceGetAttribute(&cus, hipDeviceAttributeMultiprocessorCount, dev);
    hipFuncSetAttribute((const void*)mega, hipFuncAttributeMaxDynamicSharedMemorySize, SHM_B + 16);
    hipOccupancyMaxActiveBlocksPerMultiprocessor(&per_cu, (const void*)mega, NTHR, SHM_B + 16);
    if (per_cu < 1) { fprintf(stderr, "kernel_launch: occupancy query says %d blocks/CU\n", per_cu); per_cu = 1; }
    grid_blocks = cus * 1;
    (void)hipGetLastError();
  }
  if (grid_blocks < 0) return;
  (void)hipMemsetAsync((unsigned char*)d_ws + WS_BAR, 0, 16384, stream);
  Params hp{};
  for (int i = 0; i < 23; ++i) hp.in[i] = (const float*)d_in[i];
  hp.out = (float*)d_out; hp.ws = (unsigned char*)d_ws;
  void* args[] = {&hp};
  hipError_t e = hipLaunchCooperativeKernel((const void*)mega, dim3(grid_blocks), dim3(NTHR), args, SHM_B + 16, stream);
  if (e != hipSuccess) fprintf(stderr, "cooperative launch failed: %s (grid %d)\n", hipGetErrorString(e), grid_blocks);
}
```

```cpp
#include <hip/hip_runtime.h>
#include <hip/hip_bf16.h>
#include <hip/hip_cooperative_groups.h>
#include <cstdio>
namespace cg = cooperative_groups;

typedef unsigned short u16;
using bf16x8 = __attribute__((ext_vector_type(8))) short;
using f32x4 = __attribute__((ext_vector_type(4))) float;
using f32x16 = __attribute__((ext_vector_type(16))) float;
#define DI __device__ __forceinline__

constexpr int DM = 1024, SEQ = 8192, MR = 16384, NMETA = 16, MALL = MR + NMETA, MPAD = 16640;
constexpr int DFF = 2816, DEPTH = 4;
constexpr int NTHR = 512;
#define DUP_CONV 0
#define DUP_ATTN 0
#define DUP_GU 0
#define DUP_SKINNY 0
constexpr float EPS = 1e-6f;

constexpr size_t al256(size_t x) { return (x + 255) & ~(size_t)255; }
constexpr size_t WS_XN = 0;
constexpr size_t WS_G = WS_XN + al256((size_t)MPAD * 1024 * 2);
constexpr size_t G_BYTES = (size_t)MPAD * DFF * 2;
constexpr size_t WS_WGU = WS_G + al256(G_BYTES);
constexpr size_t WGU_ONE = (size_t)2 * DFF * 1024 * 2;
constexpr size_t WS_WD = WS_WGU + 8 * WGU_ONE;
constexpr size_t WD_ONE = (size_t)1024 * DFF * 2;
constexpr size_t WS_WPOOL = WS_WD + 8 * WD_ONE;
constexpr size_t WS_WDKV = WS_WPOOL + (size_t)8 * 65536 * 2;
constexpr size_t WS_WUKV = WS_WDKV + (size_t)512 * 1024 * 2;
constexpr size_t WS_WDQ = WS_WUKV + (size_t)1024 * 256 * 2;
constexpr size_t WS_WUQ = WS_WDQ + (size_t)2 * 512 * 1024 * 2;
constexpr size_t WS_WO = WS_WUQ + (size_t)2 * 768 * 384 * 2;
constexpr size_t WS_KF = WS_WO + (size_t)2 * 1024 * 512 * 2;
constexpr size_t WS_LO = WS_KF;
constexpr size_t WS_VT = WS_KF + (size_t)2 * 8 * 8192 * 96 * 2;
constexpr size_t WS_KM = WS_VT + (size_t)2 * 8 * 64 * 8192 * 2;
constexpr size_t WS_VM = WS_KM + (size_t)8 * 64 * 96 * 2;
constexpr size_t WS_HM = WS_VM + (size_t)8 * 64 * 64 * 2;
constexpr size_t WS_ROPE = WS_HM + (size_t)16 * 1024 * 4;
constexpr size_t WS_SS = WS_ROPE + al256((size_t)8208 * 16 * 8);
constexpr int NSLOT = 16, SSLD = 16512, SLOT_Q = 13, SLOT_KV = 15;
constexpr size_t WS_CKV = WS_SS + (size_t)NSLOT * SSLD * 4;
constexpr size_t WS_BAR = WS_CKV + al256((size_t)MPAD * 256 * 2);
constexpr size_t WS_END = WS_BAR + 16384;
constexpr size_t GA_P = 0;
constexpr size_t GA_CQ = 0;
constexpr size_t GA_CQN = al256((size_t)MPAD * 384 * 4);
constexpr size_t GA_Q = GA_CQN + al256((size_t)MPAD * 384 * 2);
constexpr size_t GA_O = GA_Q + al256((size_t)MPAD * 768 * 2);
static_assert(GA_O + (size_t)MPAD * 512 * 2 <= G_BYTES, "alias overflow");
static_assert((size_t)MPAD * 1024 * 2 <= (size_t)2 * 8 * 8192 * 96 * 2 + (size_t)2 * 8 * 64 * 8192 * 2, "LO must fit the old K/V region");
constexpr size_t KF_ELEMS = (size_t)2 * 8 * 8192 * 96;
static_assert((KF_ELEMS + (size_t)2 * 8 * 64 * 8192) * 2 <= (size_t)MR * DM * 4, "K/V must fit d_out");

struct Params { const float* in[23]; float* out; unsigned char* ws; };
typedef const __attribute__((address_space(4))) Params* PP;
__device__ __forceinline__ PP launder(PP q) {
  unsigned long long v = (unsigned long long)q;
  unsigned lo = __builtin_amdgcn_readfirstlane((unsigned)v), hi = __builtin_amdgcn_readfirstlane((unsigned)(v >> 32));
  asm volatile("" : "+s"(lo), "+s"(hi));
  return (PP)(((unsigned long long)hi << 32) | lo);
}

__device__ __forceinline__ int ogdim() { int g = __builtin_amdgcn_readfirstlane(gridDim.x); asm volatile("" : "+s"(g)); return g; }
__device__ __forceinline__ int obid() { int b = __builtin_amdgcn_readfirstlane(blockIdx.x); asm volatile("" : "+s"(b)); return b; }
__device__ __forceinline__ int otid() { int t = threadIdx.x; asm volatile("" : "+v"(t)); return t; }
DI u16 f2bf(float x) { return __builtin_bit_cast(u16, (__bf16)x); }
DI float bf2f(u16 v) { return __uint_as_float(((unsigned)v) << 16); }
DI float xhalf_max(float v) {
  const unsigned u = __float_as_uint(v);
  const auto r = __builtin_amdgcn_permlane32_swap(u, u, false, false);
  return fmaxf(__uint_as_float(r[0]), __uint_as_float(r[1]));
}
DI float xhalf_sum(float v) {
  const unsigned u = __float_as_uint(v);
  const auto r = __builtin_amdgcn_permlane32_swap(u, u, false, false);
  return __uint_as_float(r[0]) + __uint_as_float(r[1]);
}
DI float wave_sum(float v) {
  for (int o = 32; o > 0; o >>= 1) v += __shfl_xor(v, o);
  return v;
}
DI float silu_mul(float g, float u) { return g * __builtin_amdgcn_rcpf(1.f + __expf(-g)) * u; }
DI int row_pos(int row) { return row < MR ? (row & (SEQ - 1)) + NMETA : row - MR; }
DI int permt(int t) { return (t & ~12) | ((t & 4) << 1) | ((t & 8) >> 1); }

DI f32x4 hl_sum(unsigned h01, unsigned h23, unsigned l01, unsigned l23) {
  f32x4 r;
  r[0] = __uint_as_float(h01 << 16) + __uint_as_float(l01 << 16);
  r[1] = __uint_as_float(h01 & 0xffff0000u) + __uint_as_float(l01 & 0xffff0000u);
  r[2] = __uint_as_float(h23 << 16) + __uint_as_float(l23 << 16);
  r[3] = __uint_as_float(h23 & 0xffff0000u) + __uint_as_float(l23 & 0xffff0000u);
  return r;
}
DI void hl_split(f32x4 h, ushort4& hi, ushort4& lo) {
  hi = (ushort4){f2bf(h[0]), f2bf(h[1]), f2bf(h[2]), f2bf(h[3])};
  lo.x = f2bf(h[0] - bf2f(hi.x)); lo.y = f2bf(h[1] - bf2f(hi.y)); lo.z = f2bf(h[2] - bf2f(hi.z)); lo.w = f2bf(h[3] - bf2f(hi.w));
}
DI float* hrow_ptr(float* Hr, float* Hm, int row) { return row < MR ? Hr + (size_t)row * DM : Hm + (size_t)(row - MR) * DM; }
DI float rs_of(const float* ss, int row, float invn) { return rsqrtf(ss[row] * invn + EPS); }
DI ushort4 pk4(f32x4 v) { ushort4 o; o.x = f2bf(v[0]); o.y = f2bf(v[1]); o.z = f2bf(v[2]); o.w = f2bf(v[3]); return o; }
DI void row_ss_add(float* ss, int row, float part, bool valid) {
  part += __shfl_xor(part, 16); part += __shfl_xor(part, 32);
  if (valid && (__lane_id() < 16)) atomicAdd(ss + row, part);
}
DI f32x4 swiglu4(f32x4 g, f32x4 u, float r) {
  const float a = -1.4426950408889634f * r, b = r * r;
  const f32x4 t = g * a;
  f32x4 d;
  d[0] = __builtin_amdgcn_rcpf(1.f + __builtin_amdgcn_exp2f(t[0])); d[1] = __builtin_amdgcn_rcpf(1.f + __builtin_amdgcn_exp2f(t[1]));
  d[2] = __builtin_amdgcn_rcpf(1.f + __builtin_amdgcn_exp2f(t[2])); d[3] = __builtin_amdgcn_rcpf(1.f + __builtin_amdgcn_exp2f(t[3]));
  return (g * u) * (d * b);
}
struct EpiSwiglu {
  static constexpr bool GU = true, PERM = true;
  u16* G; const float* ssin;
  DI void colpre(int, f32x4&, f32x4&) const {}
  DI void pre(int row, int, float& r, f32x4&, f32x4&) const { r = ssin[row]; }
  DI void op(int row, int col, f32x4 g, f32x4 u, float r) const {
    r = rsqrtf(r * (1.f / DM) + EPS);
    *(ushort4*)(G + (size_t)row * DFF + col) = pk4(swiglu4(g, u, r));
  }
  DI void op8(int row, int col, f32x4 g0, f32x4 u0, f32x4 g1, f32x4 u1, float r) const {
    r = rsqrtf(r * (1.f / DM) + EPS);
    const ushort4 a = pk4(swiglu4(g0, u0, r)), b = pk4(swiglu4(g1, u1, r));
    bf16x8 o = {(short)a.x, (short)a.y, (short)a.z, (short)a.w, (short)b.x, (short)b.y, (short)b.z, (short)b.w};
    *(bf16x8*)(G + (size_t)row * DFF + col) = o;
  }
};
struct EpiNull {
  static constexpr bool GU = true, PERM = true;
  u16* G;
  DI void colpre(int, f32x4&, f32x4&) const {}
  DI void pre(int, int, float&, f32x4&, f32x4&) const {}
  DI void op(int row, int col, f32x4 g, f32x4 u, float) const { if (g[0] + u[1] + g[2] + u[3] == 12345.678f) G[(size_t)row * DFF + col] = 1; }
  DI void op8(int row, int col, f32x4 g, f32x4 u, f32x4, f32x4, float) const { if (g[0] + u[1] + g[2] + u[3] == 12345.678f) G[(size_t)row * DFF + col] = 1; }
};
template <bool HAS_CS>
struct EpiResidT {
  static constexpr bool GU = false, PERM = true;
  static constexpr int BATCH_ROWS = HAS_CS ? 2 : 4;
  u16* HI; u16* LO; float* ssout; const float* cs; float scale;
  template <int D1> DI void colpre(int col, f32x4& c0, f32x4& c1) const {
    c0 = (f32x4){scale, scale, scale, scale}; c1 = c0;
    if (HAS_CS) { c0 *= *(const f32x4*)(cs + col); c1 *= *(const f32x4*)(cs + col + D1); }
  }
  template <int D1> DI void pre(int row, int col, float&, f32x4& x0, f32x4& x1) const {
    const size_t o = (size_t)row * DM + col;
    if (D1 == 4) { x0 = *(const f32x4*)(HI + o); x1 = *(const f32x4*)(LO + o); }
    else {
      const uint2 a = *(const uint2*)(HI + o), b = *(const uint2*)(LO + o), c = *(const uint2*)(HI + o + D1), d = *(const uint2*)(LO + o + D1);
      x0 = (f32x4){__uint_as_float(a.x), __uint_as_float(a.y), __uint_as_float(b.x), __uint_as_float(b.y)};
      x1 = (f32x4){__uint_as_float(c.x), __uint_as_float(c.y), __uint_as_float(d.x), __uint_as_float(d.y)};
    }
  }
  template <int D1> DI void op(int row, int col, f32x4 v0, f32x4 v1, float, f32x4 x0, f32x4 x1, f32x4 c0, f32x4 c1) const {
    const size_t o = (size_t)row * DM + col;
    f32x4 h0, h1;
    if (D1 == 4) {
      h0 = hl_sum(__float_as_uint(x0[0]), __float_as_uint(x0[1]), __float_as_uint(x1[0]), __float_as_uint(x1[1])) + c0 * v0;
      h1 = hl_sum(__float_as_uint(x0[2]), __float_as_uint(x0[3]), __float_as_uint(x1[2]), __float_as_uint(x1[3])) + c1 * v1;
    } else {
      h0 = hl_sum(__float_as_uint(x0[0]), __float_as_uint(x0[1]), __float_as_uint(x0[2]), __float_as_uint(x0[3])) + c0 * v0;
      h1 = hl_sum(__float_as_uint(x1[0]), __float_as_uint(x1[1]), __float_as_uint(x1[2]), __float_as_uint(x1[3])) + c1 * v1;
    }
    ushort4 ha, la, hb, lb;
    hl_split(h0, ha, la); hl_split(h1, hb, lb);
    if (D1 == 4) {
      const bf16x8 hv = {(short)ha.x, (short)ha.y, (short)ha.z, (short)ha.w, (short)hb.x, (short)hb.y, (short)hb.z, (short)hb.w};
      const bf16x8 lv = {(short)la.x, (short)la.y, (short)la.z, (short)la.w, (short)lb.x, (short)lb.y, (short)lb.z, (short)lb.w};
      *(bf16x8*)(HI + o) = hv; *(bf16x8*)(LO + o) = lv;
    } else {
      *(ushort4*)(HI + o) = ha; *(ushort4*)(LO + o) = la; *(ushort4*)(HI + o + D1) = hb; *(ushort4*)(LO + o + D1) = lb;
    }
    const f32x4 q = h0 * h0 + h1 * h1;
    row_ss_add(ssout, row, q[0] + q[1] + q[2] + q[3], true);
  }
};
struct EpiDQ {
  static constexpr int BATCH_ROWS = 4;
  static constexpr bool GU = false, PERM = true;
  u16* CB; const float* ssin; float* ssout;
  template <int D1> DI void colpre(int, f32x4&, f32x4&) const {}
  template <int D1> DI void pre(int row, int, float& r, f32x4&, f32x4&) const { r = ssin[row]; }
  template <int D1> DI void op(int row, int col, f32x4 v0, f32x4 v1, float r, f32x4, f32x4, f32x4, f32x4) const {
    r = rsqrtf(r * (1.f / DM) + EPS);
    const bool ok = col < 384;
    v0 *= r; v1 *= r;
    if (ok) { *(ushort4*)(CB + (size_t)row * 384 + col) = pk4(v0); *(ushort4*)(CB + (size_t)row * 384 + col + D1) = pk4(v1); }
    const f32x4 q = v0 * v0 + v1 * v1;
    row_ss_add(ssout, row, ok ? q[0] + q[1] + q[2] + q[3] : 0.f, ok);
  }
};
struct EpiDKV {
  static constexpr int BATCH_ROWS = 4;
  static constexpr bool GU = false, PERM = false;
  u16* CB; const float* ssin; float* ssout; const float* rope; u16* Kf; u16* Km;
  template <int D1> DI void colpre(int, f32x4&, f32x4&) const {}
  template <int D1> DI void pre(int row, int col, float& r, f32x4& x0, f32x4& x1) const {
    r = ssin[row];
    if ((col & ~31) == 256) { const float* rp = rope + (size_t)(row_pos(row) * 16 + (col & 15)) * 2; x0 = *(const f32x4*)rp; x1 = *(const f32x4*)(rp + 4); }
  }
  template <int D1> DI void op(int row, int col, f32x4 v0, f32x4 v1, float r, f32x4 ra, f32x4 rb, f32x4, f32x4) const {
    static_assert(D1 == 16, "rotary pairs are 16 columns apart");
    r = rsqrtf(r * (1.f / DM) + EPS);
    v0 *= r; v1 *= r;
    const bool ok = col < 256;
    if (ok) { *(ushort4*)(CB + (size_t)row * 256 + col) = pk4(v0); *(ushort4*)(CB + (size_t)row * 256 + col + 16) = pk4(v1); }
    const f32x4 q = v0 * v0 + v1 * v1;
    row_ss_add(ssout, row, ok ? q[0] + q[1] + q[2] + q[3] : 0.f, ok);
    if ((col & ~31) == 256) {
      const f32x4 c = {ra[0], ra[2], rb[0], rb[2]}, s = {ra[1], ra[3], rb[1], rb[3]};
      const ushort4 o1 = pk4(v0 * c - v1 * s), o2 = pk4(v1 * c + v0 * s);
      const int i0 = col & 15;
      for (int h = 0; h < 8; ++h) {
        u16* kd = row < MR ? Kf + ((size_t)((row >> 13) * 8 + h) * SEQ + (row & (SEQ - 1))) * 96
                           : Km + (h * 64 + (row - MR)) * 96;
        *(ushort4*)(kd + 64 + i0) = o1; *(ushort4*)(kd + 80 + i0) = o2;
      }
    }
  }
};
struct EpiQ {
  static constexpr int BATCH_ROWS = 4;
  static constexpr bool GU = false, PERM = false;
  u16* Q; const float* rope; const float* ssin; float qs;
  template <int D1> DI void colpre(int, f32x4&, f32x4&) const {}
  template <int D1> DI void pre(int row, int col, float& r, f32x4& x0, f32x4& x1) const {
    r = ssin[row];
    if (((col & ~31) % 96) == 64) { const float* rp = rope + (size_t)(row_pos(row) * 16 + (col & 15)) * 2; x0 = *(const f32x4*)rp; x1 = *(const f32x4*)(rp + 4); }
  }
  template <int D1> DI void op(int row, int col, f32x4 v0, f32x4 v1, float r, f32x4 ra, f32x4 rb, f32x4, f32x4) const {
    static_assert(D1 == 16, "rotary pairs are 16 columns apart");
    r = rsqrtf(r * (1.f / 384.f) + EPS) * qs;
    v0 *= r; v1 *= r;
    if (((col & ~31) % 96) == 64) {
      const f32x4 c = {ra[0], ra[2], rb[0], rb[2]}, s = {ra[1], ra[3], rb[1], rb[3]};
      const f32x4 o1 = v0 * c - v1 * s, o2 = v1 * c + v0 * s;
      v0 = o1; v1 = o2;
    }
    *(ushort4*)(Q + (size_t)row * 768 + col) = pk4(v0);
    *(ushort4*)(Q + (size_t)row * 768 + col + 16) = pk4(v1);
  }
};
struct EpiKV {
  static constexpr int BATCH_ROWS = 4;
  static constexpr bool GU = false, PERM = true;
  u16 *Kf, *Vt, *Km, *Vm; const float* ssin;
  template <int D1> DI void colpre(int, f32x4&, f32x4&) const {}
  template <int D1> DI void pre(int row, int, float& r, f32x4&, f32x4&) const { r = ssin[row]; }
  DI void one(int row, int col, f32x4 v) const {
    if (col < 512) {
      const int h = col >> 6, d = col & 63;
      u16* kd = row < MR ? Kf + ((size_t)((row >> 13) * 8 + h) * SEQ + (row & (SEQ - 1))) * 96 + d
                         : Km + (h * 64 + (row - MR)) * 96 + d;
      *(ushort4*)kd = pk4(v);
    } else {
      const int c = col - 512, h = c >> 6, dv = c & 63;
      u16* vd = row < MR ? Vt + ((size_t)((row >> 13) * 8 + h) * 64 + dv) * SEQ + permt(row & (SEQ - 1))
                         : Vm + (h * 64 + dv) * 64 + permt(row - MR);
      const int st = row < MR ? SEQ : 64;
      vd[0] = f2bf(v[0]); vd[st] = f2bf(v[1]); vd[2 * st] = f2bf(v[2]); vd[3 * st] = f2bf(v[3]);
    }
  }
  template <int D1> DI void op(int row, int col, f32x4 v0, f32x4 v1, float r, f32x4, f32x4, f32x4, f32x4) const {
    r = rsqrtf(r * (1.f / 256.f) + EPS);
    one(row, col, v0 * r); one(row, col + D1, v1 * r);
  }
};

#define LAS __attribute__((address_space(3)))
constexpr int BM = 256, BK = 64, HALF = 128, HTB = HALF * BK * 2, SHM_B = 8 * HTB;
DI int lds_byte(int r, int c) {
  const int st = (r >> 4) * 2 + (c >> 5), rr = r & 15, cc = c & 31, ob = rr * 64 + cc * 2;
  return st * 1024 + (ob ^ (((ob >> 9) & 1) << 5));
}
DI int perm32(int rho) { const int n = rho >> 4, i = rho & 15; return 8 * (i >> 2) + 4 * n + (i & 3); }
DI void stage_rc(int b, int& R, int& C) {
  const int st = b / 1024, sb = b % 1024, swz = sb ^ (((sb >> 9) & 1) << 5);
  R = (st >> 1) * 16 + swz / 64; C = (st & 1) * 32 + (swz % 64) / 2;
}
struct Gemm { const u16* A; const u16* Bt; int lda, ldb, K, nN, a_pn_el, boff; };
DI bool unit_next(int i, int nN, int boff, int& pm, int& pn) {
  const int nM = MR / BM, nwg = nM * nN, G = gridDim.x;
  const long L = (long)i * G + (int)(((unsigned)obid() + (unsigned)boff) % (unsigned)G); if (L >= nwg) return false;
  int wgid = (int)L; { const int q = nwg / 8, r = nwg % 8, xcd = wgid % 8, off = wgid / 8; wgid = (xcd < r ? xcd * (q + 1) : r * (q + 1) + (xcd - r) * q) + off; }
  const int WGM = nN >= 8 ? 4 : 8;
  const int nig = WGM * nN, gid = wgid / nig, fm = gid * WGM, gsz = (nM - fm) < WGM ? (nM - fm) : WGM;
  pm = fm + ((wgid % nig) % gsz); pn = (wgid % nig) / gsz; return true;
}

template <class Epi>
__device__ __forceinline__ void gemm_phase(const Gemm g, const Epi& E) {
  extern __shared__ __attribute__((aligned(16))) unsigned char shm_raw[];
  LAS unsigned char* lds = (LAS unsigned char*)shm_raw;
  const int tid = otid(), wid = __builtin_amdgcn_readfirstlane(tid >> 6), lane = tid & 63, wr = wid >> 2, wc = wid & 3, fr = lane & 15, fq = lane >> 4;
  const int K = g.K, nt = K / BK;
  unsigned voffA[2], voffB[2];
#pragma unroll
  for (int i = 0; i < 2; ++i) { int R, C; stage_rc(tid * 16 + i * 8192, R, C);
    const int Rb = Epi::PERM ? ((R & ~31) + perm32(R & 31)) : R;
    voffA[i] = (unsigned)(R * g.lda + C) * 2u; voffB[i] = (unsigned)(Rb * g.ldb + C) * 2u; }
  const size_t kstep = (size_t)(BK * 2);
  const size_t hstepA = (size_t)HALF * g.lda * 2, hstepB = (size_t)HALF * g.ldb * 2;
  const unsigned ldsw = (unsigned)wid * 1024u;
  const int aoff = lds_byte(wr * 64 + fr, fq * 8), boff = lds_byte(wc * 32 + fr, fq * 8);
#define PG8_SA(b, h) (((b) * 2 + (h)) * HTB)
#define PG8_SB(b, h) ((4 + (b) * 2 + (h)) * HTB)
#define PG8_STAGE(bufoff, gbase, voff) do { _Pragma("unroll") for (int _i = 0; _i < 2; ++_i) \
    __builtin_amdgcn_global_load_lds((const unsigned*)((const char*)(gbase) + (voff)[_i]), (LAS unsigned*)(lds + (bufoff) + ldsw + _i * 8192), 16, 0, 0); } while (0)
#define PG8_LDA(dst, b, h) do { _Pragma("unroll") for (int m = 0; m < 4; ++m) _Pragma("unroll") for (int k = 0; k < 2; ++k) dst[m][k] = *(const LAS bf16x8*)(lds + PG8_SA(b, h) + aoff + m * 2048 + k * 1024); } while (0)
#define PG8_LDB(dst, b, h) do { _Pragma("unroll") for (int n = 0; n < 2; ++n) _Pragma("unroll") for (int k = 0; k < 2; ++k) dst[n][k] = *(const LAS bf16x8*)(lds + PG8_SB(b, h) + boff + n * 2048 + k * 1024); } while (0)
#define PG8_MMA(ai, bj, At_, Bt_) do { __builtin_amdgcn_s_setprio(1); _Pragma("unroll") for (int m = 0; m < 4; ++m) _Pragma("unroll") for (int n = 0; n < 2; ++n) _Pragma("unroll") for (int k = 0; k < 2; ++k) \
    acc[ai][bj][m][n] = __builtin_amdgcn_mfma_f32_16x16x32_bf16(Bt_[n][k], At_[m][k], acc[ai][bj][m][n], 0, 0, 0); __builtin_amdgcn_s_setprio(0); } while (0)
#define PG8_WAIT_V(n) asm volatile("s_waitcnt vmcnt(" #n ")" ::: "memory")
#define PG8_WAIT_L(n) asm volatile("s_waitcnt lgkmcnt(" #n ")" ::: "memory")
#define PG8_BAR __builtin_amdgcn_s_barrier()
#define PG8_SCHED __builtin_amdgcn_sched_barrier(0)
  int cpm, cpn, npm = 0, npn = 0, ui = 0;
  if (!unit_next(0, g.nN, g.boff, cpm, cpn)) return;
  f32x4 acc[2][2][4][2];
#pragma unroll
  for (int a = 0; a < 2; ++a)
#pragma unroll
    for (int b = 0; b < 2; ++b)
#pragma unroll
      for (int m = 0; m < 4; ++m)
#pragma unroll
        for (int n = 0; n < 2; ++n) acc[a][b][m][n] = (f32x4){0.f, 0.f, 0.f, 0.f};
  bf16x8 At[4][2], B0[2][2], B1[2][2];
  const char* cA = (const char*)(g.A + (size_t)cpn * g.a_pn_el) + (size_t)cpm * 2 * hstepA;
  const char* cB = (const char*)g.Bt + (size_t)cpn * 2 * hstepB;
  PG8_STAGE(PG8_SB(0, 0), cB, voffB); PG8_STAGE(PG8_SA(0, 0), cA, voffA); PG8_STAGE(PG8_SB(0, 1), cB + hstepB, voffB); PG8_STAGE(PG8_SA(0, 1), cA + hstepA, voffA);
  if (wr == 1) PG8_BAR;
  PG8_WAIT_V(4); PG8_BAR;
  PG8_STAGE(PG8_SB(1, 0), cB + kstep, voffB); PG8_STAGE(PG8_SA(1, 0), cA + kstep, voffA); PG8_STAGE(PG8_SB(1, 1), cB + hstepB + kstep, voffB);
  PG8_WAIT_V(6); PG8_BAR;
  for (;;) {
    const bool has_next = unit_next(ui + 1, g.nN, g.boff, npm, npn);
    const char* nA = has_next ? (const char*)(g.A + (size_t)npn * g.a_pn_el) + (size_t)npm * 2 * hstepA : cA;
    const char* nB = has_next ? (const char*)g.Bt + (size_t)npn * 2 * hstepB : cB;
#pragma unroll 1
    for (int t = 0; t < nt; t += 2) {
      const bool last = (t == nt - 2);
      const char* a1 = cA + (size_t)(t + 1) * kstep;
      const char* a2 = last ? nA : cA + (size_t)(t + 2) * kstep; const char* b2 = last ? nB : cB + (size_t)(t + 2) * kstep;
      const char* a3 = a2 + kstep; const char* b3 = b2 + kstep;
      PG8_LDB(B0, 0, 0); PG8_SCHED; PG8_LDA(At, 0, 0); PG8_STAGE(PG8_SA(1, 1), a1 + hstepA, voffA);
      PG8_WAIT_L(8); PG8_BAR; PG8_WAIT_L(0); PG8_MMA(0, 0, At, B0); PG8_BAR; PG8_SCHED;
      PG8_LDB(B1, 0, 1); PG8_STAGE(PG8_SB(0, 0), b2, voffB);
      PG8_BAR; PG8_WAIT_L(0); PG8_MMA(0, 1, At, B1); PG8_BAR;
      PG8_LDA(At, 0, 1); PG8_STAGE(PG8_SA(0, 0), a2, voffA);
      PG8_BAR; PG8_WAIT_L(0); PG8_MMA(1, 0, At, B0); PG8_BAR; PG8_SCHED;
      PG8_STAGE(PG8_SB(0, 1), b2 + hstepB, voffB);
      PG8_WAIT_V(6); PG8_BAR; PG8_MMA(1, 1, At, B1); PG8_BAR;
      PG8_LDB(B0, 1, 0); PG8_SCHED; PG8_LDA(At, 1, 0); PG8_STAGE(PG8_SA(0, 1), a2 + hstepA, voffA);
      PG8_WAIT_L(8); PG8_BAR; PG8_WAIT_L(0); PG8_MMA(0, 0, At, B0); PG8_BAR; PG8_SCHED;
      PG8_LDB(B1, 1, 1); PG8_STAGE(PG8_SB(1, 0), b3, voffB);
      PG8_BAR; PG8_WAIT_L(0); PG8_MMA(0, 1, At, B1); PG8_BAR;
      PG8_LDA(At, 1, 1); PG8_STAGE(PG8_SA(1, 0), a3, voffA);
      PG8_BAR; PG8_WAIT_L(0); PG8_MMA(1, 0, At, B0); PG8_BAR; PG8_SCHED;
      PG8_STAGE(PG8_SB(1, 1), b3 + hstepB, voffB);
      PG8_WAIT_V(6); PG8_BAR; PG8_MMA(1, 1, At, B1); PG8_BAR;
    }
    {
      const int t2 = otid(), wid2 = __builtin_amdgcn_readfirstlane(t2 >> 6), wr2 = wid2 >> 2, wc2 = wid2 & 3, fr2 = t2 & 15, fq2 = (t2 & 63) >> 4;
      const int row0 = cpm * BM + wr2 * 64 + fr2;
      const f32x4 z4 = {0.f, 0.f, 0.f, 0.f};
      constexpr int D1 = Epi::PERM ? 4 : 16, FQ = Epi::PERM ? 8 : 4;
      if constexpr (Epi::GU) {
        const int col0 = cpn * HALF + wc2 * 32 + FQ * fq2;
#pragma unroll
        for (int ai = 0; ai < 2; ++ai) {
          float rr[4]; f32x4 xa = z4, xb_ = z4;
#pragma unroll
          for (int m = 0; m < 4; ++m) { rr[m] = 0.f; E.pre(row0 + ai * HALF + m * 16, col0, rr[m], xa, xb_); }
#pragma unroll
          for (int m = 0; m < 4; ++m)
            E.op8(row0 + ai * HALF + m * 16, col0, acc[ai][0][m][0], acc[ai][1][m][0], acc[ai][0][m][1], acc[ai][1][m][1], rr[m]);
        }
      } else {
        const int col0 = cpn * BM + wc2 * 32 + FQ * fq2;
        f32x4 c0[2], c1[2];
#pragma unroll
        for (int bj = 0; bj < 2; ++bj) { c0[bj] = z4; c1[bj] = z4; E.template colpre<D1>(col0 + bj * HALF, c0[bj], c1[bj]); }
        constexpr int BR = Epi::BATCH_ROWS;
#pragma unroll
        for (int am = 0; am < 8 / BR; ++am) {
          const int r0b = am * BR;
          float rr[BR][2]; f32x4 x0[BR][2], x1[BR][2];
#pragma unroll
          for (int m = 0; m < BR; ++m)
#pragma unroll
            for (int bj = 0; bj < 2; ++bj) { const int rs = r0b + m; rr[m][bj] = 0.f; x0[m][bj] = z4; x1[m][bj] = z4;
              E.template pre<D1>(row0 + (rs >> 2) * HALF + (rs & 3) * 16, col0 + bj * HALF, rr[m][bj], x0[m][bj], x1[m][bj]); }
#pragma unroll
          for (int m = 0; m < BR; ++m)
#pragma unroll
            for (int bj = 0; bj < 2; ++bj) { const int rs = r0b + m;
              E.template op<D1>(row0 + (rs >> 2) * HALF + (rs & 3) * 16, col0 + bj * HALF, acc[rs >> 2][bj][rs & 3][0], acc[rs >> 2][bj][rs & 3][1], rr[m][bj], x0[m][bj], x1[m][bj], c0[bj], c1[bj]); }
        }
      }
    }
    if (!has_next) break;
#pragma unroll
    for (int a = 0; a < 2; ++a)
#pragma unroll
      for (int b = 0; b < 2; ++b)
#pragma unroll
        for (int m = 0; m < 4; ++m)
#pragma unroll
          for (int n = 0; n < 2; ++n) acc[a][b][m][n] = (f32x4){0.f, 0.f, 0.f, 0.f};
    cpm = npm; cpn = npn; cA = nA; cB = nB; ++ui;
  }
  PG8_WAIT_V(0);
  if (wr == 0) PG8_BAR;
  PG8_BAR;
#undef PG8_SA
#undef PG8_SB
#undef PG8_STAGE
#undef PG8_LDA
#undef PG8_LDB
#undef PG8_MMA
}

template <class Epi>
__device__ __forceinline__ void skinny(const Gemm g, int nitems, const Epi& E, int first_block = 0) {
  extern __shared__ __attribute__((aligned(16))) float sk_red[];
  const int tid = otid(), wave = __builtin_amdgcn_readfirstlane(tid >> 6), lane = tid & 63, G = gridDim.x;
  const int fr = lane & 15, fq = lane >> 4;
  const int nks = g.K >> 5;
  for (int it = (first_block ? (int)blockIdx.x - first_block + (blockIdx.x < (unsigned)first_block ? (1 << 28) : 0) : G - 1 - (int)blockIdx.x); it < nitems; it += (first_block ? G - first_block : G)) {
    int r0, r1, col, pn;
    if (Epi::GU) { pn = it >> 3; const int w = (it & 7) * 16; r0 = pn * 256 + w; r1 = r0 + 128; col = pn * 128 + w; }
    else { r0 = it * 32; r1 = r0 + 16; col = it * 32; pn = col >> 8; }
    const u16* ap = g.A + (size_t)pn * g.a_pn_el + (size_t)(MR + fr) * g.lda + fq * 8;
    const u16* b0p = g.Bt + (size_t)(r0 + fr) * g.ldb + fq * 8;
    const u16* b1p = g.Bt + (size_t)(r1 + fr) * g.ldb + fq * 8;
    f32x4 a0 = {0.f, 0.f, 0.f, 0.f}, a1 = {0.f, 0.f, 0.f, 0.f};
#pragma unroll 4
    for (int ks = wave; ks < nks; ks += 8) {
      const int k = ks * 32;
      const bf16x8 a = *(const bf16x8*)(ap + k);
      const bf16x8 b0 = *(const bf16x8*)(b0p + k);
      const bf16x8 b1 = *(const bf16x8*)(b1p + k);
      a0 = __builtin_amdgcn_mfma_f32_16x16x32_bf16(b0, a, a0, 0, 0, 0);
      a1 = __builtin_amdgcn_mfma_f32_16x16x32_bf16(b1, a, a1, 0, 0, 0);
    }
    __syncthreads();
    float* my = sk_red + (wave * 64 + lane) * 8;
    *(f32x4*)my = a0; *(f32x4*)(my + 4) = a1;
    __syncthreads();
    if (wave == 0) {
      f32x4 s0 = {0.f, 0.f, 0.f, 0.f}, s1 = {0.f, 0.f, 0.f, 0.f};
#pragma unroll
      for (int w = 0; w < 8; ++w) { s0 += *(const f32x4*)(sk_red + (w * 64 + lane) * 8); s1 += *(const f32x4*)(sk_red + (w * 64 + lane) * 8 + 4); }
      float r = 0.f; f32x4 x0 = {0.f, 0.f, 0.f, 0.f}, x1 = x0, c0 = x0, c1 = x0;
      if constexpr (Epi::GU) { E.pre(MR + fr, col + 4 * fq, r, x0, x1); E.op(MR + fr, col + 4 * fq, s0, s1, r); }
      else {
        E.template colpre<16>(col + 4 * fq, c0, c1);
        E.template pre<16>(MR + fr, col + 4 * fq, r, x0, x1);
        E.template op<16>(MR + fr, col + 4 * fq, s0, s1, r, x0, x1, c0, c1);
      }
    }
  }
  __syncthreads();
}
template <class Epi>
__device__ __forceinline__ void gemm_all(const Gemm g, int n_skinny, const Epi& E, int first_block = 0) {
  gemm_phase<Epi>(g, E);
  skinny<Epi>(g, n_skinny, E, first_block);
}

__device__ __forceinline__ void conv_tile(const float* __restrict__ src, int sld, int c0, int cvalid_end, int k0, int kend,
                          u16* __restrict__ dst, int dld, int r0, const float* __restrict__ gain) {
  extern __shared__ __attribute__((aligned(16))) float ctile[];
  const int tid = otid();
  __syncthreads();
  {
    const int j = tid & 63, i0 = tid >> 6;
    const bool cok = c0 + j < cvalid_end;
    float v[32];
#pragma unroll
    for (int e = 0; e < 32; ++e) {
      const int k = k0 + i0 + e * 8;
      v[e] = (cok && k < kend) ? src[(size_t)k * sld + c0 + j] : 0.f;
    }
    if (gain) {
#pragma unroll
      for (int e = 0; e < 32; ++e) { const int k = k0 + i0 + e * 8; v[e] *= (k < kend) ? gain[k] : 0.f; }
    }
#pragma unroll
    for (int e = 0; e < 32; ++e) ctile[(i0 + e * 8) * 65 + j] = v[e];
  }
  __syncthreads();
  {
    const int j = tid >> 3, ic = tid & 7;
#pragma unroll
    for (int q = 0; q < 4; ++q) {
      const int kk = (q * 8 + ic) * 8;
      if (k0 + kk < kend) {
        bf16x8 v;
#pragma unroll
        for (int e = 0; e < 8; ++e) v[e] = (short)f2bf(ctile[(kk + e) * 65 + j]);
        *(bf16x8*)(dst + (size_t)(r0 + j) * dld + k0 + kk) = v;
      }
    }
  }
}
__device__ __forceinline__ void conv_seg(const float* src, int sld, int c0, int ncols_valid, int ncols_pad, int K, u16* dst, int dld, int r0, const float* gain) {
  const int nct = ncols_pad / 64, nkt = (K + 255) / 256;
  for (int t = blockIdx.x; t < nct * nkt; t += gridDim.x) {
    const int ct = t % nct, kt = t / nct;
    conv_tile(src, sld, c0 + ct * 64, c0 + ncols_valid, kt * 256, K, dst, dld, r0 + ct * 64, gain);
  }
}

__device__ __forceinline__ void conv_ffn(PP p, int f, int t0, int stride, int tbeg = 0, int tend = 528) {
  unsigned char* ws = p->ws;
  const int l = f >> 1, s2 = f & 1;
  for (int t = tbeg + t0; t < tend; t += stride) {
    if (t < 352) {
      const int which = t & 1, n64 = (t >> 1) % 44, kt = (t >> 1) / 44;
      const float* src = p->in[(s2 ? 8 : 3) + which] + (size_t)l * 1024 * DFF;
      u16* dst = (u16*)(ws + WS_WGU + (size_t)f * WGU_ONE);
      conv_tile(src, DFF, n64 * 64, DFF, kt * 256, 1024, dst, 1024, (n64 >> 1) * 256 + which * 128 + (n64 & 1) * 64, p->in[s2 ? 7 : 2] + l * DM);
    } else {
      const int r = t - 352, ct = r % 16, kt = r / 16;
      const float* src = p->in[s2 ? 10 : 5] + (size_t)l * DFF * 1024;
      u16* dst = (u16*)(ws + WS_WD + (size_t)f * WD_ONE);
      conv_tile(src, 1024, ct * 64, 1024, kt * 256, DFF, dst, DFF, ct * 64, nullptr);
    }
  }
  __syncthreads();
}
__device__ __forceinline__ void conv_small(PP p) {
  unsigned char* ws = p->ws;
  for (int t = blockIdx.x; t < 256; t += gridDim.x) {
    const float* src; const float* gain = nullptr; u16* dst; int sld, c0, cend, k0, kend, dld, r0;
    if (t < 32) {
      const int i = t >> 2, ct = t & 3;
      src = p->in[11] + (size_t)i * 65536; sld = 256; c0 = ct * 64; cend = 256; k0 = 0; kend = 256;
      dst = (u16*)(ws + WS_WPOOL) + (size_t)i * 65536; dld = 256; r0 = ct * 64;
    } else if (t < 64) {
      const int r = t - 32, ct = r & 7, kt = r >> 3;
      src = p->in[14]; sld = 288; c0 = ct * 64; cend = 288; k0 = kt * 256; kend = 1024;
      dst = (u16*)(ws + WS_WDKV); dld = 1024; r0 = ct * 64; gain = p->in[13];
    } else if (t < 80) {
      const int r = t - 64, which = r >> 3, ct = r & 7;
      src = p->in[16 + which]; sld = 512; c0 = ct * 64; cend = 512; k0 = 0; kend = 256;
      dst = (u16*)(ws + WS_WUKV); dld = 256; r0 = which * 512 + ct * 64; gain = p->in[15];
    } else {
      const int r = (t - 80) % 88, j = (t - 80) / 88;
      if (r < 32) {
        const int ct = r & 7, kt = r >> 3;
        src = p->in[18] + (size_t)j * 1024 * 384; sld = 384; c0 = ct * 64; cend = 384; k0 = kt * 256; kend = 1024;
        dst = (u16*)(ws + WS_WDQ) + (size_t)j * 512 * 1024; dld = 1024; r0 = ct * 64; gain = p->in[6] + (2 + j) * DM;
      } else if (r < 56) {
        const int q = r - 32, ct = q % 12, kt = q / 12;
        src = p->in[20] + (size_t)j * 384 * 768; sld = 768; c0 = ct * 64; cend = 768; k0 = kt * 256; kend = 384;
        dst = (u16*)(ws + WS_WUQ) + (size_t)j * 768 * 384; dld = 384; r0 = ct * 64; gain = p->in[19] + j * 384;
      } else {
        const int q = r - 56, ct = q & 15, kt = q >> 4;
        src = p->in[21] + (size_t)j * 512 * 1024; sld = 1024; c0 = ct * 64; cend = 1024; k0 = kt * 256; kend = 512;
        dst = (u16*)(ws + WS_WO) + (size_t)j * 1024 * 512; dld = 512; r0 = ct * 64;
      }
    }
    conv_tile(src, sld, c0, cend, k0, kend, dst, dld, r0, gain);
  }
  __syncthreads();
}

template <int MODE>
__device__ __forceinline__ void norm_rows(PP p, const float* __restrict__ gain) {
  const int tid = otid(), wave = tid >> 6, lane = tid & 63;
  u16* HI = (u16*)(p->ws + WS_XN); u16* LO = (u16*)(p->ws + WS_LO);
  float* ss0 = (float*)(p->ws + WS_SS);
  const int nrows = (MODE == 2) ? MR : MALL;
  constexpr int NB = 4;
  const int stride = gridDim.x * 8;
  for (int row0 = blockIdx.x * 8 + wave; row0 < nrows; row0 += NB * stride) {
    f32x4 v[NB][4];
#pragma unroll
    for (int k = 0; k < NB; ++k) {
      const int row = row0 + k * stride;
      if (row < nrows) {
        if (MODE == 1) {
          const float* src = row < MR ? p->in[0] + (size_t)row * DM : p->in[1] + (size_t)(row - MR) * DM;
#pragma unroll
          for (int i = 0; i < 4; ++i) v[k][i] = ((const f32x4*)src)[i * 64 + lane];
        } else {
#pragma unroll
          for (int i = 0; i < 4; ++i) {
            const uint2 a = ((const uint2*)(HI + (size_t)row * DM))[i * 64 + lane], b = ((const uint2*)(LO + (size_t)row * DM))[i * 64 + lane];
            v[k][i] = hl_sum(a.x, a.y, b.x, b.y);
          }
        }
      } else {
#pragma unroll
        for (int i = 0; i < 4; ++i) v[k][i] = (f32x4){0.f, 0.f, 0.f, 0.f};
      }
    }
#pragma unroll
    for (int k = 0; k < NB; ++k) {
      const int row = row0 + k * stride;
      float ss = 0.f;
#pragma unroll
      for (int i = 0; i < 4; ++i) { const f32x4 q = v[k][i] * v[k][i]; ss += q[0] + q[1] + q[2] + q[3]; }
      ss = wave_sum(ss);
      if (row < nrows) {
        if (MODE == 1) {
          if (lane == 0) ss0[row] = ss;
#pragma unroll
          for (int i = 0; i < 4; ++i) {
            ushort4 hi, lo; hl_split(v[k][i], hi, lo);
            ((ushort4*)(HI + (size_t)row * DM))[i * 64 + lane] = hi;
            ((ushort4*)(LO + (size_t)row * DM))[i * 64 + lane] = lo;
          }
        } else {
          const float r = rsqrtf(ss * (1.f / DM) + EPS);
#pragma unroll
          for (int i = 0; i < 4; ++i) {
            const f32x4 g = ((const f32x4*)gain)[i * 64 + lane];
            ((f32x4*)(p->out + (size_t)row * DM))[i * 64 + lane] = v[k][i] * g * r;
          }
        }
      }
    }
  }
}

template <int W>
__device__ __forceinline__ void pool_seg(const u16* __restrict__ HB, const float* __restrict__ ss, const float* __restrict__ gain,
                                         u16* __restrict__ P, int b, int t0, int c8) {
  constexpr int NR = W - 1 + 8;
  bf16x8 v[NR]; float rr[NR];
#pragma unroll
  for (int j = 0; j < NR; ++j) {
    const int q = NMETA + t0 - (W - 1) + j;
    const int r = q >= NMETA ? b * SEQ + q - NMETA : MR + q;
    v[j] = *(const bf16x8*)(HB + (size_t)r * DM + c8 * 8);
    rr[j] = ss[r];
  }
  const f32x4 g0 = *(const f32x4*)(gain + c8 * 8), g1 = *(const f32x4*)(gain + c8 * 8 + 4);
  float S[8];
#pragma unroll
  for (int e = 0; e < 8; ++e) S[e] = 0.f;
#pragma unroll
  for (int j = 0; j < NR; ++j) {
    const float rj = rsqrtf(rr[j] * (1.f / DM) + EPS);
    float u[8];
#pragma unroll
    for (int e = 0; e < 8; ++e) { u[e] = bf2f((u16)v[j][e]) * rj; S[e] += u[e]; }
    if (j >= W - 1) {
      bf16x8 o;
#pragma unroll
      for (int e = 0; e < 8; ++e) o[e] = (short)f2bf((S[e] * (1.f / W) - u[e]) * (e < 4 ? g0[e & 3] : g1[e & 3]));
      *(bf16x8*)(P + (size_t)(b * SEQ + t0 + j - (W - 1)) * DM + c8 * 8) = o;
      const float ro = rsqrtf(rr[j - (W - 1)] * (1.f / DM) + EPS);
#pragma unroll
      for (int e = 0; e < 8; ++e) S[e] -= bf2f((u16)v[j - (W - 1)][e]) * ro;
    }
  }
}
__device__ __forceinline__ void pool_phase(const u16* __restrict__ HB, const float* __restrict__ ss, const float* __restrict__ gain, u16* __restrict__ P) {
  const int nitem = 4 * 2048 * 32;
  for (int i = blockIdx.x * NTHR + otid(); i < nitem; i += gridDim.x * NTHR) {
    const int c = i & 31, bseg = (i >> 5) & 2047, g = i >> 16;
    const int b = bseg >> 10, t0 = (bseg & 1023) * 8, c8 = g * 32 + c;
    if (g == 0) pool_seg<2>(HB, ss, gain, P, b, t0, c8);
    else if (g == 1) pool_seg<4>(HB, ss, gain, P, b, t0, c8);
    else if (g == 2) pool_seg<8>(HB, ss, gain, P, b, t0, c8);
    else pool_seg<16>(HB, ss, gain, P, b, t0, c8);
  }
  for (int idx = blockIdx.x * NTHR + otid(); idx < NMETA * 128; idx += gridDim.x * NTHR) {
    const int pos = idx >> 7, c8 = idx & 127, w = 2 << (c8 >> 5);
    const int cnt = min(w, pos + 1);
    float acc[8], self[8];
#pragma unroll
    for (int e = 0; e < 8; ++e) { acc[e] = 0.f; self[e] = 0.f; }
    bf16x8 v[16]; float rr[16];
#pragma unroll
    for (int j = 0; j < 16; ++j) {
      v[j] = (bf16x8){0, 0, 0, 0, 0, 0, 0, 0}; rr[j] = 1.f;
      if (j < cnt) { const int r = MR + pos - j; v[j] = *(const bf16x8*)(HB + (size_t)r * DM + c8 * 8); rr[j] = ss[r]; }
    }
#pragma unroll
    for (int j = 0; j < 16; ++j) {
      const float rj = (j < cnt) ? rsqrtf(rr[j] * (1.f / DM) + EPS) : 0.f;
#pragma unroll
      for (int e = 0; e < 8; ++e) { const float f = bf2f((u16)v[j][e]) * rj; acc[e] += f; if (j == 0) self[e] = f; }
    }
    const float inv = 1.f / (float)cnt;
    const f32x4 g0 = *(const f32x4*)(gain + c8 * 8), g1 = *(const f32x4*)(gain + c8 * 8 + 4);
    bf16x8 o;
#pragma unroll
    for (int e = 0; e < 8; ++e) o[e] = (short)f2bf((acc[e] * inv - self[e]) * (e < 4 ? g0[e & 3] : g1[e & 3]));
    *(bf16x8*)(P + (size_t)(MR + pos) * DM + c8 * 8) = o;
  }
}

constexpr int KPITCH = 208, VPITCH = 144, KBYTES = 64 * KPITCH, ABUF = KBYTES + 64 * VPITCH;
__device__ __forceinline__ void attn_block(PP p, int b, int h, int qb) {
  extern __shared__ __attribute__((aligned(16))) unsigned char alds[];
  const int tid = otid(), wave = tid >> 6, lane = tid & 63, l32 = lane & 31, hl = lane >> 5;
  const u16* Q = (const u16*)(p->ws + WS_G + GA_Q);
  u16* O = (u16*)(p->ws + WS_G + GA_O);
  const bool meta = qb < 0;
  int qrow, cw, cmax;
  if (!meta) { qrow = b * SEQ + qb * 256 + wave * 32 + l32; cw = qb * 4 + (wave >> 1); cmax = qb * 4 + 3; }
  else { qrow = MR + min(l32, 15); cw = (wave == 0) ? -1 : -2; cmax = -1; }
  bf16x8 qf[6];
  {
    const u16* qp = Q + (size_t)qrow * 768 + h * 96 + hl * 8;
#pragma unroll
    for (int ks = 0; ks < 6; ++ks) qf[ks] = *(const bf16x8*)(qp + ks * 16);
  }
  f32x16 o0, o1;
#pragma unroll
  for (int i = 0; i < 16; ++i) { o0[i] = 0.f; o1[i] = 0.f; }
  float mrun = -1e30f, lsum = 0.f;
  const u16* Kg = (const u16*)p->out + (size_t)((b * 8 + h) * SEQ) * 96;
  const u16* Vg = (const u16*)p->out + KF_ELEMS + (size_t)((b * 8 + h) * 64) * SEQ;
  const u16* Kmg = (const u16*)(p->ws + WS_KM) + h * 64 * 96;
  const u16* Vmg = (const u16*)(p->ws + WS_VM) + h * 64 * 64;
  const int vdv = tid >> 3, vpart = tid & 7;
  const int kw0 = (tid / 12) * KPITCH + (tid % 12) * 16;
  const int kw1 = ((tid + 512) / 12) * KPITCH + ((tid + 512) % 12) * 16;
  const int vw = KBYTES + vdv * VPITCH + vpart * 16;
  uint4 kr0, kr1 = make_uint4(0, 0, 0, 0), vr;
#define ATT_LOAD(kt) do { const uint4* ks_ = (const uint4*)((kt) < 0 ? Kmg : Kg + (size_t)(kt) * 64 * 96); \
    kr0 = ks_[tid]; if (tid < 256) kr1 = ks_[tid + 512]; \
    vr = *(const uint4*)((kt) < 0 ? Vmg + vdv * 64 + vpart * 8 : Vg + (size_t)vdv * SEQ + (kt) * 64 + vpart * 8); } while (0)
#define ATT_WRITE(buf) do { unsigned char* b_ = alds + (buf) * ABUF; *(uint4*)(b_ + kw0) = kr0; if (tid < 256) *(uint4*)(b_ + kw1) = kr1; \
    *(uint4*)(b_ + vw) = vr; } while (0)
  ATT_LOAD(-1);
  ATT_WRITE(0);
  __syncthreads();
  int it = 0;
  for (int kt = -1; kt <= cmax; ++kt, ++it) {
    const int buf = it & 1;
    if (kt < cmax) ATT_LOAD(kt + 1);
    if (kt <= cw) {
      const unsigned char* kb = alds + buf * ABUF;
      const unsigned char* vb = kb + KBYTES;
      f32x16 s0, s1;
#pragma unroll
      for (int i = 0; i < 16; ++i) { s0[i] = 0.f; s1[i] = 0.f; }
#pragma unroll
      for (int ks = 0; ks < 6; ++ks) {
        const bf16x8 k0 = *(const bf16x8*)(kb + l32 * KPITCH + ks * 32 + hl * 16);
        const bf16x8 k1 = *(const bf16x8*)(kb + (32 + l32) * KPITCH + ks * 32 + hl * 16);
        s0 = __builtin_amdgcn_mfma_f32_32x32x16_bf16(k0, qf[ks], s0, 0, 0, 0);
        s1 = __builtin_amdgcn_mfma_f32_32x32x16_bf16(k1, qf[ks], s1, 0, 0, 0);
      }
      if (kt < 0) {
#pragma unroll
        for (int i = 8; i < 16; ++i) s0[i] = -1e30f;
#pragma unroll
        for (int i = 0; i < 16; ++i) s1[i] = -1e30f;
      }
      float mx = s0[0];
#pragma unroll
      for (int i = 1; i < 16; ++i) mx = fmaxf(mx, s0[i]);
#pragma unroll
      for (int i = 0; i < 16; ++i) mx = fmaxf(mx, s1[i]);
      mx = xhalf_max(mx);
      const float mnew = fmaxf(mrun, mx);
      const float alpha = __builtin_amdgcn_exp2f(mrun - mnew);
      mrun = mnew;
      float ps = 0.f;
#pragma unroll
      for (int i = 0; i < 16; ++i) { s0[i] = __builtin_amdgcn_exp2f(s0[i] - mnew); ps += s0[i]; }
#pragma unroll
      for (int i = 0; i < 16; ++i) { s1[i] = __builtin_amdgcn_exp2f(s1[i] - mnew); ps += s1[i]; }
      lsum = lsum * alpha + ps;
#pragma unroll
      for (int i = 0; i < 16; ++i) { o0[i] *= alpha; o1[i] *= alpha; }
#pragma unroll
      for (int jp = 0; jp < 4; ++jp) {
        bf16x8 pf;
#pragma unroll
        for (int e = 0; e < 8; ++e) pf[e] = (short)f2bf((jp < 2) ? s0[(jp & 1) * 8 + e] : s1[(jp & 1) * 8 + e]);
        const bf16x8 v0 = *(const bf16x8*)(vb + l32 * VPITCH + (jp * 16 + hl * 8) * 2);
        const bf16x8 v1 = *(const bf16x8*)(vb + (32 + l32) * VPITCH + (jp * 16 + hl * 8) * 2);
        o0 = __builtin_amdgcn_mfma_f32_32x32x16_bf16(v0, pf, o0, 0, 0, 0);
        o1 = __builtin_amdgcn_mfma_f32_32x32x16_bf16(v1, pf, o1, 0, 0, 0);
        }
    }
    if (kt < cmax) ATT_WRITE(buf ^ 1);
    __syncthreads();
  }
#undef ATT_LOAD
#undef ATT_WRITE
  const float ltot = xhalf_sum(lsum);
  if (cw >= -1 && (!meta || l32 < 16)) {
    const float inv = 1.f / ltot;
    u16* op = O + (size_t)qrow * 512 + h * 64 + 4 * hl;
#pragma unroll
    for (int g4 = 0; g4 < 4; ++g4) {
      ushort4 a, c;
      a.x = f2bf(o0[g4 * 4 + 0] * inv); a.y = f2bf(o0[g4 * 4 + 1] * inv); a.z = f2bf(o0[g4 * 4 + 2] * inv); a.w = f2bf(o0[g4 * 4 + 3] * inv);
      c.x = f2bf(o1[g4 * 4 + 0] * inv); c.y = f2bf(o1[g4 * 4 + 1] * inv); c.z = f2bf(o1[g4 * 4 + 2] * inv); c.w = f2bf(o1[g4 * 4 + 3] * inv);
      *(ushort4*)(op + 8 * g4) = a;
      *(ushort4*)(op + 32 + 8 * g4) = c;
    }
  }
}

__device__ __forceinline__ void attn_phase(PP p) {
  const int G = gridDim.x;
  for (int it = blockIdx.x; it < 256; it += G) {
    const int nsub = it < 256 ? 2 : 1;
    for (int sub = 0; sub < nsub; ++sub) {
      int b, h, qb;
      if (it < 256) { const int bh = it >> 4, i = it & 15; b = bh >> 3; h = bh & 7; qb = sub ? i : 31 - i; }
      else { b = 0; h = it - 256; qb = -1; }
      attn_block(p, b, h, qb);
    }
  }
}

__device__ __forceinline__ void misc_init(PP p) {
  float2* rope = (float2*)(p->ws + WS_ROPE);
  for (int idx = blockIdx.x * NTHR + otid(); idx < 8208 * 16; idx += gridDim.x * NTHR) {
    const int pos = idx >> 4, i = idx & 15;
    const float inv = 1.0f / powf(10000.f, (float)(2 * i) / 32.f);
    const float ang = (float)pos * inv;
    float s, c; sincosf(ang, &s, &c);
    rope[idx] = make_float2(c, s);
  }
  unsigned* z = (unsigned*)(p->ws + WS_KM);
  const int nz = (int)((WS_HM - WS_KM) / 4);
  for (int idx = blockIdx.x * NTHR + otid(); idx < nz; idx += gridDim.x * NTHR) z[idx] = 0u;
  unsigned* zs = (unsigned*)(p->ws + WS_SS) + SSLD;
  for (int idx = blockIdx.x * NTHR + otid(); idx < (NSLOT - 1) * SSLD; idx += gridDim.x * NTHR) zs[idx] = 0u;
}

#define XB_TMO      128
#define XB_XCNT(j)  (256  + 64 * (j))
#define XB_XSUB(j)  (1280 + 64 * (j))
#define XB_XGEN(j)  (2304 + 64 * (j))
#define XB_TOP      3328
#define XB_TOPGEN   3392
#define XCD_BAR_WORDS 3456
#define XB_SPIN_CAP (1u << 20)
DI unsigned xb_ld(unsigned* p)              { return __hip_atomic_load(p, __ATOMIC_RELAXED, __HIP_MEMORY_SCOPE_AGENT); }
DI unsigned xb_add(unsigned* p, unsigned v) { return __hip_atomic_fetch_add(p, v, __ATOMIC_RELAXED, __HIP_MEMORY_SCOPE_AGENT); }
DI unsigned xb_xcc_id() { return (unsigned)__builtin_amdgcn_s_getreg((3 << 11) | 20) & 0xFu; }
#define XB_SPIN(cond, bar) do { unsigned _sp = 0; while (cond) { __builtin_amdgcn_s_sleep(1); \
    if ((++_sp & 255u) == 0u) { if (xb_ld(&(bar)[XB_TMO])) break; if (_sp > XB_SPIN_CAP) { atomicAdd(&(bar)[XB_TMO], 1u); break; } } } } while (0)
struct XcdBarrier { unsigned* bar; unsigned x; volatile LAS unsigned* st; };
DI XcdBarrier xcd_barrier_post(unsigned* bar, volatile LAS unsigned* st) {
  XcdBarrier b; b.bar = bar; b.x = xb_xcc_id(); b.st = st;
  if (threadIdx.x == 0) (void)xb_add(&bar[XB_XCNT(b.x)], 1u);
  return b;
}
DI void xcd_barrier_complete(unsigned* bar, unsigned x, unsigned& nloc, unsigned& nx) {
  const unsigned G = gridDim.x * gridDim.y * gridDim.z;
  unsigned sum, cnt, mine, sp = 0u;
  for (;;) {
    sum = 0u; cnt = 0u; mine = 0u;
#pragma unroll
    for (unsigned j = 0; j < 16; ++j) { const unsigned c = xb_ld(&bar[XB_XCNT(j)]); sum += c; cnt += (c > 0u) ? 1u : 0u; mine = (j == x) ? c : mine; }
    if (sum == G) break;
    __builtin_amdgcn_s_sleep(1);
    if ((++sp & 255u) == 0u) { if (xb_ld(&bar[XB_TMO])) break; if (sp > XB_SPIN_CAP) { atomicAdd(&bar[XB_TMO], 1u); break; } }
  }
  nloc = mine > 0u ? mine : 1u; nx = cnt > 0u ? cnt : 1u;
}
DI void xcd_barrier(const XcdBarrier& b) {
  asm volatile("s_waitcnt vmcnt(0)" ::: "memory");
  __syncthreads();
  if (threadIdx.x == 0) {
    unsigned* bar = b.bar;
    unsigned bx = __builtin_amdgcn_readfirstlane(b.x); asm volatile("" : "+s"(bx));
    __builtin_amdgcn_s_waitcnt(0);
    unsigned nloc = b.st[0], nx = b.st[1];
    if (nloc == 0u) { xcd_barrier_complete(bar, bx, nloc, nx); b.st[0] = nloc; b.st[1] = nx; }
    const unsigned old = xb_add(&bar[XB_XSUB(bx)], 1u);
    const unsigned gen = old / nloc;
    if (old + 1u == (gen + 1u) * nloc) {
      __builtin_amdgcn_fence(__ATOMIC_RELEASE, "agent");
      asm volatile("s_waitcnt vmcnt(0)" ::: "memory");
      const unsigned og = xb_add(&bar[XB_TOP], 1u);
      const unsigned tg = og / nx;
      if (og + 1u == (tg + 1u) * nx) xb_add(&bar[XB_TOPGEN], 1u);
      else XB_SPIN(xb_ld(&bar[XB_TOPGEN]) == tg, bar);
      __builtin_amdgcn_fence(__ATOMIC_ACQUIRE, "agent");
      xb_add(&bar[XB_XGEN(bx)], 1u);
      asm volatile("s_waitcnt vmcnt(0)" ::: "memory");
    } else {
      XB_SPIN(xb_ld(&bar[XB_XGEN(bx)]) == gen, bar);
      __builtin_amdgcn_fence(__ATOMIC_ACQUIRE, "agent");
      asm volatile("s_waitcnt vmcnt(0)" ::: "memory");
    }
  }
  __syncthreads();
}

#define GSYNC() do { xcd_barrier(xb); p = launder(p); } while (0)
__device__ __forceinline__ void ffn(PP p, int f, int sin, int sout, const XcdBarrier& xb, bool with_kv, bool meta) {
  if (with_kv) {
    unsigned char* ws = p->ws; float* SS = (float*)(ws + WS_SS);
    EpiDKV E{(u16*)(ws + WS_CKV), SS + (size_t)sin * SSLD, SS + (size_t)SLOT_KV * SSLD, (const float*)(ws + WS_ROPE), (u16*)p->out, (u16*)(ws + WS_KM)};
    gemm_all<EpiDKV>(Gemm{(const u16*)(ws + WS_XN), (const u16*)(ws + WS_WDKV), 1024, 1024, 1024, 2, 0, 128}, 9, E);
  }
  {
    unsigned char* ws = p->ws;
    EpiSwiglu E{(u16*)(ws + WS_G), (const float*)(ws + WS_SS) + (size_t)sin * SSLD};
    gemm_all<EpiSwiglu>(Gemm{(const u16*)(ws + WS_XN), (const u16*)(ws + WS_WGU + (size_t)f * WGU_ONE), 1024, 1024, 1024, 22, 0, 0}, meta ? DFF / 16 : 0, E, ogdim() == 256 ? 128 : 0);
    if (f < 7) { const int gd = ogdim(), bid = obid();
      if (gd == 256) { if (bid >= 128) { if (f == 0) conv_ffn(p, 0, bid - 128, 128, 352, 528); conv_ffn(p, f + 1, bid - 128, 128); } }
      else { if (f == 0) conv_ffn(p, 0, bid, gd, 352, 528); conv_ffn(p, f + 1, bid, gd); } }
    if (DUP_GU) { xcd_barrier(xb); gemm_phase<EpiSwiglu>(Gemm{(const u16*)(ws + WS_XN), (const u16*)(ws + WS_WGU + (size_t)f * WGU_ONE), 1024, 1024, 1024, 22, 0, 0}, E); }
    if (DUP_SKINNY) { xcd_barrier(xb); skinny<EpiSwiglu>(Gemm{(const u16*)(ws + WS_XN), (const u16*)(ws + WS_WGU + (size_t)f * WGU_ONE), 1024, 1024, 1024, 22, 0, 0}, DFF / 16, E); }
  }
  GSYNC();
  {
    unsigned char* ws = p->ws;
    EpiResidT<false> E{(u16*)(ws + WS_XN), (u16*)(ws + WS_LO), (float*)(ws + WS_SS) + (size_t)sout * SSLD, nullptr, 0.5f};
    gemm_all<EpiResidT<false>>(Gemm{(const u16*)(ws + WS_G), (const u16*)(ws + WS_WD + (size_t)f * WD_ONE), DFF, DFF, DFF, 4, 0, 0}, meta ? 1024 / 32 : 0, E);
  }
  if (with_kv) {
    unsigned char* ws = p->ws; float* SS = (float*)(ws + WS_SS);
    EpiKV E{(u16*)p->out, (u16*)p->out + KF_ELEMS, (u16*)(ws + WS_KM), (u16*)(ws + WS_VM), SS + (size_t)SLOT_KV * SSLD};
    gemm_all<EpiKV>(Gemm{(const u16*)(ws + WS_CKV), (const u16*)(ws + WS_WUKV), 256, 256, 256, 4, 0, 0}, 32, E);
  }
  GSYNC();
}

__global__ void __launch_bounds__(NTHR, 2) mega(Params p_unused) {
  extern __shared__ __attribute__((aligned(16))) unsigned char shm_top[];
  cg::grid_group grid = cg::this_grid();
  PP p = launder((PP)__builtin_amdgcn_kernarg_segment_ptr());

  if (threadIdx.x < 4) ((volatile LAS unsigned*)((LAS unsigned char*)shm_top + SHM_B))[threadIdx.x] = 0u;
  if (gridDim.x == 0x7fffffffu) grid.sync();
  norm_rows<1>(p, nullptr);
  misc_init(p);
  conv_ffn(p, 0, blockIdx.x, gridDim.x, 0, 352);
  conv_small(p);
  p = launder(p);
  const XcdBarrier xb = xcd_barrier_post((unsigned*)(p->ws + WS_BAR), (volatile LAS unsigned*)((LAS unsigned char*)shm_top + SHM_B));
  GSYNC();

  for (int l = 0; l < DEPTH; ++l) {
    ffn(p, l * 2, 3 * l, 3 * l + 1, xb, l == 2, l < 2);
    unsigned char* ws = p->ws;
    float* SS = (float*)(ws + WS_SS);
    u16* HB = (u16*)(ws + WS_XN);
    float* Hm = (float*)(ws + WS_HM);
    if (l < 2) {
      u16* P = (u16*)(ws + WS_G + GA_P);
      pool_phase(HB, SS + (size_t)(3 * l + 1) * SSLD, p->in[6] + l * DM, P);
      GSYNC();
      ws = p->ws; SS = (float*)(ws + WS_SS); HB = (u16*)(ws + WS_XN); Hm = (float*)(ws + WS_HM); P = (u16*)(ws + WS_G + GA_P);
      {
        EpiResidT<true> E{HB, (u16*)(ws + WS_LO), SS + (size_t)(3 * l + 2) * SSLD, p->in[12] + l * DM, 1.f};
        gemm_all<EpiResidT<true>>(Gemm{P, (const u16*)(ws + WS_WPOOL) + (size_t)l * 4 * 65536, 1024, 256, 256, 4, 256, 0}, 32, E);
      }
      GSYNC();
    } else {
      const int j = l - 2;
      {
        EpiDQ E{(u16*)(ws + WS_G + GA_CQN), SS + (size_t)(3 * l + 1) * SSLD, SS + (size_t)(SLOT_Q + j) * SSLD};
        gemm_all<EpiDQ>(Gemm{HB, (const u16*)(ws + WS_WDQ) + (size_t)j * 512 * 1024, 1024, 1024, 1024, 2, 0, 0}, 0, E);
      }
      GSYNC();
      ws = p->ws; SS = (float*)(ws + WS_SS);
      {
        EpiQ E{(u16*)(ws + WS_G + GA_Q), (const float*)(ws + WS_ROPE), SS + (size_t)(SLOT_Q + j) * SSLD, 0.10206207261596577f * 1.4426950408889634f};
        gemm_all<EpiQ>(Gemm{(const u16*)(ws + WS_G + GA_CQN), (const u16*)(ws + WS_WUQ) + (size_t)j * 768 * 384, 384, 384, 384, 3, 0, 0}, 0, E);
      }
      GSYNC();
      attn_phase(p);
      if (DUP_ATTN) { GSYNC(); attn_phase(p); }
      GSYNC();
      ws = p->ws; SS = (float*)(ws + WS_SS); HB = (u16*)(ws + WS_XN); Hm = (float*)(ws + WS_HM);
      {
        EpiResidT<false> E{HB, (u16*)(ws + WS_LO), SS + (size_t)(3 * l + 2) * SSLD, nullptr, 1.f};
        gemm_all<EpiResidT<false>>(Gemm{(const u16*)(ws + WS_G + GA_O), (const u16*)(ws + WS_WO) + (size_t)j * 1024 * 512, 512, 512, 512, 4, 0, 0}, 0, E);
      }
      GSYNC();
    }
    ffn(p, l * 2 + 1, 3 * l + 2, 3 * l + 3, xb, false, l < 2);
  }
  norm_rows<2>(p, p->in[22]);
}

extern "C" void kernel_launch(void* const* d_in, const int* in_sizes, int n_in, void* d_out, int out_size,
                              void* d_ws, size_t ws_size, hipStream_t stream) {
  static int grid_blocks = 0;
  if (grid_blocks == 0) {
    if (n_in != 23 || out_size != MR * DM || ws_size < WS_END) {
      fprintf(stderr, "kernel_launch: unexpected problem (n_in %d out %d ws %zu need %zu)\n", n_in, out_size, ws_size, (size_t)WS_END);
      grid_blocks = -1; return;
    }
    int dev = 0, cus = 0, per_cu = 0;
    hipGetDevice(&dev);
    hipDeviceGetAttribute(&cus, hipDeviceAttributeMultiprocessorCount, dev);
    hipFuncSetAttribute((const void*)mega, hipFuncAttributeMaxDynamicSharedMemorySize, SHM_B + 16);
    hipOccupancyMaxActiveBlocksPerMultiprocessor(&per_cu, (const void*)mega, NTHR, SHM_B + 16);
    if (per_cu < 1) { fprintf(stderr, "kernel_launch: occupancy query says %d blocks/CU\n", per_cu); per_cu = 1; }
    grid_blocks = cus * 1;
    (void)hipGetLastError();
  }
  if (grid_blocks < 0) return;
  (void)hipMemsetAsync((unsigned char*)d_ws + WS_BAR, 0, 16384, stream);
  Params hp{};
  for (int i = 0; i < 23; ++i) hp.in[i] = (const float*)d_in[i];
  hp.out = (float*)d_out; hp.ws = (unsigned char*)d_ws;
  void* args[] = {&hp};
  hipError_t e = hipLaunchCooperativeKernel((const void*)mega, dim3(grid_blocks), dim3(NTHR), args, SHM_B + 16, stream);
  if (e != hipSuccess) fprintf(stderr, "cooperative launch failed: %s (grid %d)\n", hipGetErrorString(e), grid_blocks);
}
```

```cpp
#include <hip/hip_runtime.h>
#include <hip/hip_bf16.h>
#include <hip/hip_cooperative_groups.h>
#include <cstdio>
namespace cg = cooperative_groups;

typedef unsigned short u16;
using bf16x8 = __attribute__((ext_vector_type(8))) short;
using f32x4 = __attribute__((ext_vector_type(4))) float;
using f32x16 = __attribute__((ext_vector_type(16))) float;
#define DI __device__ __forceinline__

constexpr int DM = 1024, SEQ = 8192, MR = 16384, NMETA = 16, MALL = MR + NMETA, MPAD = 16640;
constexpr int DFF = 2816, DEPTH = 4;
constexpr int NTHR = 512;
#define DUP_CONV 0
#define DUP_ATTN 0
#define DUP_GU 0
#define DUP_SKINNY 0
constexpr float EPS = 1e-6f;

constexpr size_t al256(size_t x) { return (x + 255) & ~(size_t)255; }
constexpr size_t WS_XN = 0;
constexpr size_t WS_G = WS_XN + al256((size_t)MPAD * 1024 * 2);
constexpr size_t G_BYTES = (size_t)MPAD * DFF * 2;
constexpr size_t WS_WGU = WS_G + al256(G_BYTES);
constexpr size_t WGU_ONE = (size_t)2 * DFF * 1024 * 2;
constexpr size_t WS_WD = WS_WGU + 8 * WGU_ONE;
constexpr size_t WD_ONE = (size_t)1024 * DFF * 2;
constexpr size_t WS_WPOOL = WS_WD + 8 * WD_ONE;
constexpr size_t WS_WDKV = WS_WPOOL + (size_t)8 * 65536 * 2;
constexpr size_t WS_WUKV = WS_WDKV + (size_t)512 * 1024 * 2;
constexpr size_t WS_WDQ = WS_WUKV + (size_t)1024 * 256 * 2;
constexpr size_t WS_WUQ = WS_WDQ + (size_t)2 * 512 * 1024 * 2;
constexpr size_t WS_WO = WS_WUQ + (size_t)2 * 768 * 384 * 2;
constexpr size_t WS_KF = WS_WO + (size_t)2 * 1024 * 512 * 2;
constexpr size_t WS_LO = WS_KF;
constexpr size_t WS_VT = WS_KF + (size_t)2 * 8 * 8192 * 96 * 2;
constexpr size_t WS_KM = WS_VT + (size_t)2 * 8 * 64 * 8192 * 2;
constexpr size_t WS_VM = WS_KM + (size_t)8 * 64 * 96 * 2;
constexpr size_t WS_HM = WS_VM + (size_t)8 * 64 * 64 * 2;
constexpr size_t WS_ROPE = WS_HM + (size_t)16 * 1024 * 4;
constexpr size_t WS_SS = WS_ROPE + al256((size_t)8208 * 16 * 8);
constexpr int NSLOT = 16, SSLD = 16512, SLOT_Q = 13, SLOT_KV = 15;
constexpr size_t WS_CKV = WS_SS + (size_t)NSLOT * SSLD * 4;
constexpr size_t WS_BAR = WS_CKV + al256((size_t)MPAD * 256 * 2);
constexpr size_t WS_END = WS_BAR + 16384;
constexpr size_t GA_P = 0;
constexpr size_t GA_CQ = 0;
constexpr size_t GA_CQN = al256((size_t)MPAD * 384 * 4);
constexpr size_t GA_Q = GA_CQN + al256((size_t)MPAD * 384 * 2);
constexpr size_t GA_O = GA_Q + al256((size_t)MPAD * 768 * 2);
static_assert(GA_O + (size_t)MPAD * 512 * 2 <= G_BYTES, "alias overflow");
static_assert((size_t)MPAD * 1024 * 2 <= (size_t)2 * 8 * 8192 * 96 * 2 + (size_t)2 * 8 * 64 * 8192 * 2, "LO must fit the old K/V region");
constexpr size_t KF_ELEMS = (size_t)2 * 8 * 8192 * 96;
static_assert((KF_ELEMS + (size_t)2 * 8 * 64 * 8192) * 2 <= (size_t)MR * DM * 4, "K/V must fit d_out");

struct Params { const float* in[23]; float* out; unsigned char* ws; };
typedef const __attribute__((address_space(4))) Params* PP;
__device__ __forceinline__ PP launder(PP q) {
  unsigned long long v = (unsigned long long)q;
  unsigned lo = __builtin_amdgcn_readfirstlane((unsigned)v), hi = __builtin_amdgcn_readfirstlane((unsigned)(v >> 32));
  asm volatile("" : "+s"(lo), "+s"(hi));
  return (PP)(((unsigned long long)hi << 32) | lo);
}

__device__ __forceinline__ int ogdim() { int g = __builtin_amdgcn_readfirstlane(gridDim.x); asm volatile("" : "+s"(g)); return g; }
__device__ __forceinline__ int obid() { int b = __builtin_amdgcn_readfirstlane(blockIdx.x); asm volatile("" : "+s"(b)); return b; }
__device__ __forceinline__ int otid() { int t = threadIdx.x; asm volatile("" : "+v"(t)); return t; }
DI u16 f2bf(float x) { return __builtin_bit_cast(u16, (__bf16)x); }
DI float bf2f(u16 v) { return __uint_as_float(((unsigned)v) << 16); }
DI float xhalf_max(float v) {
  const unsigned u = __float_as_uint(v);
  const auto r = __builtin_amdgcn_permlane32_swap(u, u, false, false);
  return fmaxf(__uint_as_float(r[0]), __uint_as_float(r[1]));
}
DI float xhalf_sum(float v) {
  const unsigned u = __float_as_uint(v);
  const auto r = __builtin_amdgcn_permlane32_swap(u, u, false, false);
  return __uint_as_float(r[0]) + __uint_as_float(r[1]);
}
DI float wave_sum(float v) {
  for (int o = 32; o > 0; o >>= 1) v += __shfl_xor(v, o);
  return v;
}
DI float silu_mul(float g, float u) { return g * __builtin_amdgcn_rcpf(1.f + __expf(-g)) * u; }
DI int row_pos(int row) { return row < MR ? (row & (SEQ - 1)) + NMETA : row - MR; }
DI int permt(int t) { return (t & ~12) | ((t & 4) << 1) | ((t & 8) >> 1); }

DI f32x4 hl_sum(unsigned h01, unsigned h23, unsigned l01, unsigned l23) {
  f32x4 r;
  r[0] = __uint_as_float(h01 << 16) + __uint_as_float(l01 << 16);
  r[1] = __uint_as_float(h01 & 0xffff0000u) + __uint_as_float(l01 & 0xffff0000u);
  r[2] = __uint_as_float(h23 << 16) + __uint_as_float(l23 << 16);
  r[3] = __uint_as_float(h23 & 0xffff0000u) + __uint_as_float(l23 & 0xffff0000u);
  return r;
}
DI void hl_split(f32x4 h, ushort4& hi, ushort4& lo) {
  hi = (ushort4){f2bf(h[0]), f2bf(h[1]), f2bf(h[2]), f2bf(h[3])};
  lo.x = f2bf(h[0] - bf2f(hi.x)); lo.y = f2bf(h[1] - bf2f(hi.y)); lo.z = f2bf(h[2] - bf2f(hi.z)); lo.w = f2bf(h[3] - bf2f(hi.w));
}
DI float* hrow_ptr(float* Hr, float* Hm, int row) { return row < MR ? Hr + (size_t)row * DM : Hm + (size_t)(row - MR) * DM; }
DI float rs_of(const float* ss, int row, float invn) { return rsqrtf(ss[row] * invn + EPS); }
DI ushort4 pk4(f32x4 v) { ushort4 o; o.x = f2bf(v[0]); o.y = f2bf(v[1]); o.z = f2bf(v[2]); o.w = f2bf(v[3]); return o; }
DI void row_ss_add(float* ss, int row, float part, bool valid) {
  part += __shfl_xor(part, 16); part += __shfl_xor(part, 32);
  if (valid && (__lane_id() < 16)) atomicAdd(ss + row, part);
}
DI f32x4 swiglu4(f32x4 g, f32x4 u, float r) {
  const float a = -1.4426950408889634f * r, b = r * r;
  const f32x4 t = g * a;
  f32x4 d;
  d[0] = __builtin_amdgcn_rcpf(1.f + __builtin_amdgcn_exp2f(t[0])); d[1] = __builtin_amdgcn_rcpf(1.f + __builtin_amdgcn_exp2f(t[1]));
  d[2] = __builtin_amdgcn_rcpf(1.f + __builtin_amdgcn_exp2f(t[2])); d[3] = __builtin_amdgcn_rcpf(1.f + __builtin_amdgcn_exp2f(t[3]));
  return (g * u) * (d * b);
}
struct EpiSwiglu {
  static constexpr bool GU = true, PERM = true;
  u16* G; const float* ssin;
  DI void colpre(int, f32x4&, f32x4&) const {}
  DI void pre(int row, int, float& r, f32x4&, f32x4&) const { r = ssin[row]; }
  DI void op(int row, int col, f32x4 g, f32x4 u, float r) const {
    r = rsqrtf(r * (1.f / DM) + EPS);
    *(ushort4*)(G + (size_t)row * DFF + col) = pk4(swiglu4(g, u, r));
  }
  DI void op8(int row, int col, f32x4 g0, f32x4 u0, f32x4 g1, f32x4 u1, float r) const {
    r = rsqrtf(r * (1.f / DM) + EPS);
    const ushort4 a = pk4(swiglu4(g0, u0, r)), b = pk4(swiglu4(g1, u1, r));
    bf16x8 o = {(short)a.x, (short)a.y, (short)a.z, (short)a.w, (short)b.x, (short)b.y, (short)b.z, (short)b.w};
    *(bf16x8*)(G + (size_t)row * DFF + col) = o;
  }
};
struct EpiNull {
  static constexpr bool GU = true, PERM = true;
  u16* G;
  DI void colpre(int, f32x4&, f32x4&) const {}
  DI void pre(int, int, float&, f32x4&, f32x4&) const {}
  DI void op(int row, int col, f32x4 g, f32x4 u, float) const { if (g[0] + u[1] + g[2] + u[3] == 12345.678f) G[(size_t)row * DFF + col] = 1; }
  DI void op8(int row, int col, f32x4 g, f32x4 u, f32x4, f32x4, float) const { if (g[0] + u[1] + g[2] + u[3] == 12345.678f) G[(size_t)row * DFF + col] = 1; }
};
template <bool HAS_CS>
struct EpiResidT {
  static constexpr bool GU = false, PERM = true;
  static constexpr int BATCH_ROWS = HAS_CS ? 2 : 4;
  u16* HI; u16* LO; float* ssout; const float* cs; float scale;
  template <int D1> DI void colpre(int col, f32x4& c0, f32x4& c1) const {
    c0 = (f32x4){scale, scale, scale, scale}; c1 = c0;
    if (HAS_CS) { c0 *= *(const f32x4*)(cs + col); c1 *= *(const f32x4*)(cs + col + D1); }
  }
  template <int D1> DI void pre(int row, int col, float&, f32x4& x0, f32x4& x1) const {
    const size_t o = (size_t)row * DM + col;
    if (D1 == 4) { x0 = *(const f32x4*)(HI + o); x1 = *(const f32x4*)(LO + o); }
    else {
      const uint2 a = *(const uint2*)(HI + o), b = *(const uint2*)(LO + o), c = *(const uint2*)(HI + o + D1), d = *(const uint2*)(LO + o + D1);
      x0 = (f32x4){__uint_as_float(a.x), __uint_as_float(a.y), __uint_as_float(b.x), __uint_as_float(b.y)};
      x1 = (f32x4){__uint_as_float(c.x), __uint_as_float(c.y), __uint_as_float(d.x), __uint_as_float(d.y)};
    }
  }
  template <int D1> DI void op(int row, int col, f32x4 v0, f32x4 v1, float, f32x4 x0, f32x4 x1, f32x4 c0, f32x4 c1) const {
    const size_t o = (size_t)row * DM + col;
    f32x4 h0, h1;
    if (D1 == 4) {
      h0 = hl_sum(__float_as_uint(x0[0]), __float_as_uint(x0[1]), __float_as_uint(x1[0]), __float_as_uint(x1[1])) + c0 * v0;
      h1 = hl_sum(__float_as_uint(x0[2]), __float_as_uint(x0[3]), __float_as_uint(x1[2]), __float_as_uint(x1[3])) + c1 * v1;
    } else {
      h0 = hl_sum(__float_as_uint(x0[0]), __float_as_uint(x0[1]), __float_as_uint(x0[2]), __float_as_uint(x0[3])) + c0 * v0;
      h1 = hl_sum(__float_as_uint(x1[0]), __float_as_uint(x1[1]), __float_as_uint(x1[2]), __float_as_uint(x1[3])) + c1 * v1;
    }
    ushort4 ha, la, hb, lb;
    hl_split(h0, ha, la); hl_split(h1, hb, lb);
    if (D1 == 4) {
      const bf16x8 hv = {(short)ha.x, (short)ha.y, (short)ha.z, (short)ha.w, (short)hb.x, (short)hb.y, (short)hb.z, (short)hb.w};
      const bf16x8 lv = {(short)la.x, (short)la.y, (short)la.z, (short)la.w, (short)lb.x, (short)lb.y, (short)lb.z, (short)lb.w};
      *(bf16x8*)(HI + o) = hv; *(bf16x8*)(LO + o) = lv;
    } else {
      *(ushort4*)(HI + o) = ha; *(ushort4*)(LO + o) = la; *(ushort4*)(HI + o + D1) = hb; *(ushort4*)(LO + o + D1) = lb;
    }
    const f32x4 q = h0 * h0 + h1 * h1;
    row_ss_add(ssout, row, q[0] + q[1] + q[2] + q[3], true);
  }
};
struct EpiDQ {
  static constexpr int BATCH_ROWS = 4;
  static constexpr bool GU = false, PERM = true;
  u16* CB; const float* ssin; float* ssout;
  template <int D1> DI void colpre(int, f32x4&, f32x4&) const {}
  template <int D1> DI void pre(int row, int, float& r, f32x4&, f32x4&) const { r = ssin[row]; }
  template <int D1> DI void op(int row, int col, f32x4 v0, f32x4 v1, float r, f32x4, f32x4, f32x4, f32x4) const {
    r = rsqrtf(r * (1.f / DM) + EPS);
    const bool ok = col < 384;
    v0 *= r; v1 *= r;
    if (ok) { *(ushort4*)(CB + (size_t)row * 384 + col) = pk4(v0); *(ushort4*)(CB + (size_t)row * 384 + col + D1) = pk4(v1); }
    const f32x4 q = v0 * v0 + v1 * v1;
    row_ss_add(ssout, row, ok ? q[0] + q[1] + q[2] + q[3] : 0.f, ok);
  }
};
struct EpiDKV {
  static constexpr int BATCH_ROWS = 4;
  static constexpr bool GU = false, PERM = false;
  u16* CB; const float* ssin; float* ssout; const float* rope; u16* Kf; u16* Km;
  template <int D1> DI void colpre(int, f32x4&, f32x4&) const {}
  template <int D1> DI void pre(int row, int col, float& r, f32x4& x0, f32x4& x1) const {
    r = ssin[row];
    if ((col & ~31) == 256) { const float* rp = rope + (size_t)(row_pos(row) * 16 + (col & 15)) * 2; x0 = *(const f32x4*)rp; x1 = *(const f32x4*)(rp + 4); }
  }
  template <int D1> DI void op(int row, int col, f32x4 v0, f32x4 v1, float r, f32x4 ra, f32x4 rb, f32x4, f32x4) const {
    static_assert(D1 == 16, "rotary pairs are 16 columns apart");
    r = rsqrtf(r * (1.f / DM) + EPS);
    v0 *= r; v1 *= r;
    const bool ok = col < 256;
    if (ok) { *(ushort4*)(CB + (size_t)row * 256 + col) = pk4(v0); *(ushort4*)(CB + (size_t)row * 256 + col + 16) = pk4(v1); }
    const f32x4 q = v0 * v0 + v1 * v1;
    row_ss_add(ssout, row, ok ? q[0] + q[1] + q[2] + q[3] : 0.f, ok);
    if ((col & ~31) == 256) {
      const f32x4 c = {ra[0], ra[2], rb[0], rb[2]}, s = {ra[1], ra[3], rb[1], rb[3]};
      const ushort4 o1 = pk4(v0 * c - v1 * s), o2 = pk4(v1 * c + v0 * s);
      const int i0 = col & 15;
      for (int h = 0; h < 8; ++h) {
        u16* kd = row < MR ? Kf + ((size_t)((row >> 13) * 8 + h) * SEQ + (row & (SEQ - 1))) * 96
                           : Km + (h * 64 + (row - MR)) * 96;
        *(ushort4*)(kd + 64 + i0) = o1; *(ushort4*)(kd + 80 + i0) = o2;
      }
    }
  }
};
struct EpiQ {
  static constexpr int BATCH_ROWS = 4;
  static constexpr bool GU = false, PERM = false;
  u16* Q; const float* rope; const float* ssin; float qs;
  template <int D1> DI void colpre(int, f32x4&, f32x4&) const {}
  template <int D1> DI void pre(int row, int col, float& r, f32x4& x0, f32x4& x1) const {
    r = ssin[row];
    if (((col & ~31) % 96) == 64) { const float* rp = rope + (size_t)(row_pos(row) * 16 + (col & 15)) * 2; x0 = *(const f32x4*)rp; x1 = *(const f32x4*)(rp + 4); }
  }
  template <int D1> DI void op(int row, int col, f32x4 v0, f32x4 v1, float r, f32x4 ra, f32x4 rb, f32x4, f32x4) const {
    static_assert(D1 == 16, "rotary pairs are 16 columns apart");
    r = rsqrtf(r * (1.f / 384.f) + EPS) * qs;
    v0 *= r; v1 *= r;
    if (((col & ~31) % 96) == 64) {
      const f32x4 c = {ra[0], ra[2], rb[0], rb[2]}, s = {ra[1], ra[3], rb[1], rb[3]};
      const f32x4 o1 = v0 * c - v1 * s, o2 = v1 * c + v0 * s;
      v0 = o1; v1 = o2;
    }
    *(ushort4*)(Q + (size_t)row * 768 + col) = pk4(v0);
    *(ushort4*)(Q + (size_t)row * 768 + col + 16) = pk4(v1);
  }
};
struct EpiKV {
  static constexpr int BATCH_ROWS = 4;
  static constexpr bool GU = false, PERM = true;
  u16 *Kf, *Vt, *Km, *Vm; const float* ssin;
  template <int D1> DI void colpre(int, f32x4&, f32x4&) const {}
  template <int D1> DI void pre(int row, int, float& r, f32x4&, f32x4&) const { r = ssin[row]; }
  DI void one(int row, int col, f32x4 v) const {
    if (col < 512) {
      const int h = col >> 6, d = col & 63;
      u16* kd = row < MR ? Kf + ((size_t)((row >> 13) * 8 + h) * SEQ + (row & (SEQ - 1))) * 96 + d
                         : Km + (h * 64 + (row - MR)) * 96 + d;
      *(ushort4*)kd = pk4(v);
    } else {
      const int c = col - 512, h = c >> 6, dv = c & 63;
      u16* vd = row < MR ? Vt + ((size_t)((row >> 13) * 8 + h) * 64 + dv) * SEQ + permt(row & (SEQ - 1))
                         : Vm + (h * 64 + dv) * 64 + permt(row - MR);
      const int st = row < MR ? SEQ : 64;
      vd[0] = f2bf(v[0]); vd[st] = f2bf(v[1]); vd[2 * st] = f2bf(v[2]); vd[3 * st] = f2bf(v[3]);
    }
  }
  template <int D1> DI void op(int row, int col, f32x4 v0, f32x4 v1, float r, f32x4, f32x4, f32x4, f32x4) const {
    r = rsqrtf(r * (1.f / 256.f) + EPS);
    one(row, col, v0 * r); one(row, col + D1, v1 * r);
  }
};

#define LAS __attribute__((address_space(3)))
constexpr int BM = 256, BK = 64, HALF = 128, HTB = HALF * BK * 2, SHM_B = 8 * HTB;
DI int lds_byte(int r, int c) {
  const int st = (r >> 4) * 2 + (c >> 5), rr = r & 15, cc = c & 31, ob = rr * 64 + cc * 2;
  return st * 1024 + (ob ^ (((ob >> 9) & 1) << 5));
}
DI int perm32(int rho) { const int n = rho >> 4, i = rho & 15; return 8 * (i >> 2) + 4 * n + (i & 3); }
DI void stage_rc(int b, int& R, int& C) {
  const int st = b / 1024, sb = b % 1024, swz = sb ^ (((sb >> 9) & 1) << 5);
  R = (st >> 1) * 16 + swz / 64; C = (st & 1) * 32 + (swz % 64) / 2;
}
struct Gemm { const u16* A; const u16* Bt; int lda, ldb, K, nN, a_pn_el, boff; };
DI bool unit_next(int i, int nN, int boff, int& pm, int& pn) {
  const int nM = MR / BM, nwg = nM * nN, G = gridDim.x;
  const long L = (long)i * G + (int)(((unsigned)obid() + (unsigned)boff) % (unsigned)G); if (L >= nwg) return false;
  int wgid = (int)L; { const int q = nwg / 8, r = nwg % 8, xcd = wgid % 8, off = wgid / 8; wgid = (xcd < r ? xcd * (q + 1) : r * (q + 1) + (xcd - r) * q) + off; }
  const int WGM = nN >= 8 ? 4 : 8;
  const int nig = WGM * nN, gid = wgid / nig, fm = gid * WGM, gsz = (nM - fm) < WGM ? (nM - fm) : WGM;
  pm = fm + ((wgid % nig) % gsz); pn = (wgid % nig) / gsz; return true;
}

template <class Epi>
__device__ __forceinline__ void gemm_phase(const Gemm g, const Epi& E) {
  extern __shared__ __attribute__((aligned(16))) unsigned char shm_raw[];
  LAS unsigned char* lds = (LAS unsigned char*)shm_raw;
  const int tid = otid(), wid = __builtin_amdgcn_readfirstlane(tid >> 6), lane = tid & 63, wr = wid >> 2, wc = wid & 3, fr = lane & 15, fq = lane >> 4;
  const int K = g.K, nt = K / BK;
  unsigned voffA[2], voffB[2];
#pragma unroll
  for (int i = 0; i < 2; ++i) { int R, C; stage_rc(tid * 16 + i * 8192, R, C);
    const int Rb = Epi::PERM ? ((R & ~31) + perm32(R & 31)) : R;
    voffA[i] = (unsigned)(R * g.lda + C) * 2u; voffB[i] = (unsigned)(Rb * g.ldb + C) * 2u; }
  const size_t kstep = (size_t)(BK * 2);
  const size_t hstepA = (size_t)HALF * g.lda * 2, hstepB = (size_t)HALF * g.ldb * 2;
  const unsigned ldsw = (unsigned)wid * 1024u;
  const int aoff = lds_byte(wr * 64 + fr, fq * 8), boff = lds_byte(wc * 32 + fr, fq * 8);
#define PG8_SA(b, h) (((b) * 2 + (h)) * HTB)
#define PG8_SB(b, h) ((4 + (b) * 2 + (h)) * HTB)
#define PG8_STAGE(bufoff, gbase, voff) do { _Pragma("unroll") for (int _i = 0; _i < 2; ++_i) \
    __builtin_amdgcn_global_load_lds((const unsigned*)((const char*)(gbase) + (voff)[_i]), (LAS unsigned*)(lds + (bufoff) + ldsw + _i * 8192), 16, 0, 0); } while (0)
#define PG8_LDA(dst, b, h) do { _Pragma("unroll") for (int m = 0; m < 4; ++m) _Pragma("unroll") for (int k = 0; k < 2; ++k) dst[m][k] = *(const LAS bf16x8*)(lds + PG8_SA(b, h) + aoff + m * 2048 + k * 1024); } while (0)
#define PG8_LDB(dst, b, h) do { _Pragma("unroll") for (int n = 0; n < 2; ++n) _Pragma("unroll") for (int k = 0; k < 2; ++k) dst[n][k] = *(const LAS bf16x8*)(lds + PG8_SB(b, h) + boff + n * 2048 + k * 1024); } while (0)
#define PG8_MMA(ai, bj, At_, Bt_) do { __builtin_amdgcn_s_setprio(1); _Pragma("unroll") for (int m = 0; m < 4; ++m) _Pragma("unroll") for (int n = 0; n < 2; ++n) _Pragma("unroll") for (int k = 0; k < 2; ++k) \
    acc[ai][bj][m][n] = __builtin_amdgcn_mfma_f32_16x16x32_bf16(Bt_[n][k], At_[m][k], acc[ai][bj][m][n], 0, 0, 0); __builtin_amdgcn_s_setprio(0); } while (0)
#define PG8_WAIT_V(n) asm volatile("s_waitcnt vmcnt(" #n ")" ::: "memory")
#define PG8_WAIT_L(n) asm volatile("s_waitcnt lgkmcnt(" #n ")" ::: "memory")
#define PG8_BAR __builtin_amdgcn_s_barrier()
#define PG8_SCHED __builtin_amdgcn_sched_barrier(0)
  int cpm, cpn, npm = 0, npn = 0, ui = 0;
  if (!unit_next(0, g.nN, g.boff, cpm, cpn)) return;
  f32x4 acc[2][2][4][2];
#pragma unroll
  for (int a = 0; a < 2; ++a)
#pragma unroll
    for (int b = 0; b < 2; ++b)
#pragma unroll
      for (int m = 0; m < 4; ++m)
#pragma unroll
        for (int n = 0; n < 2; ++n) acc[a][b][m][n] = (f32x4){0.f, 0.f, 0.f, 0.f};
  bf16x8 At[4][2], B0[2][2], B1[2][2];
  const char* cA = (const char*)(g.A + (size_t)cpn * g.a_pn_el) + (size_t)cpm * 2 * hstepA;
  const char* cB = (const char*)g.Bt + (size_t)cpn * 2 * hstepB;
  PG8_STAGE(PG8_SB(0, 0), cB, voffB); PG8_STAGE(PG8_SA(0, 0), cA, voffA); PG8_STAGE(PG8_SB(0, 1), cB + hstepB, voffB); PG8_STAGE(PG8_SA(0, 1), cA + hstepA, voffA);
  if (wr == 1) PG8_BAR;
  PG8_WAIT_V(4); PG8_BAR;
  PG8_STAGE(PG8_SB(1, 0), cB + kstep, voffB); PG8_STAGE(PG8_SA(1, 0), cA + kstep, voffA); PG8_STAGE(PG8_SB(1, 1), cB + hstepB + kstep, voffB);
  PG8_WAIT_V(6); PG8_BAR;
  for (;;) {
    const bool has_next = unit_next(ui + 1, g.nN, g.boff, npm, npn);
    const char* nA = has_next ? (const char*)(g.A + (size_t)npn * g.a_pn_el) + (size_t)npm * 2 * hstepA : cA;
    const char* nB = has_next ? (const char*)g.Bt + (size_t)npn * 2 * hstepB : cB;
#pragma unroll 1
    for (int t = 0; t < nt; t += 2) {
      const bool last = (t == nt - 2);
      const char* a1 = cA + (size_t)(t + 1) * kstep;
      const char* a2 = last ? nA : cA + (size_t)(t + 2) * kstep; const char* b2 = last ? nB : cB + (size_t)(t + 2) * kstep;
      const char* a3 = a2 + kstep; const char* b3 = b2 + kstep;
      PG8_LDB(B0, 0, 0); PG8_SCHED; PG8_LDA(At, 0, 0); PG8_STAGE(PG8_SA(1, 1), a1 + hstepA, voffA);
      PG8_WAIT_L(8); PG8_BAR; PG8_WAIT_L(0); PG8_MMA(0, 0, At, B0); PG8_BAR; PG8_SCHED;
      PG8_LDB(B1, 0, 1); PG8_STAGE(PG8_SB(0, 0), b2, voffB);
      PG8_BAR; PG8_WAIT_L(0); PG8_MMA(0, 1, At, B1); PG8_BAR;
      PG8_LDA(At, 0, 1); PG8_STAGE(PG8_SA(0, 0), a2, voffA);
      PG8_BAR; PG8_WAIT_L(0); PG8_MMA(1, 0, At, B0); PG8_BAR; PG8_SCHED;
      PG8_STAGE(PG8_SB(0, 1), b2 + hstepB, voffB);
      PG8_WAIT_V(6); PG8_BAR; PG8_MMA(1, 1, At, B1); PG8_BAR;
      PG8_LDB(B0, 1, 0); PG8_SCHED; PG8_LDA(At, 1, 0); PG8_STAGE(PG8_SA(0, 1), a2 + hstepA, voffA);
      PG8_WAIT_L(8); PG8_BAR; PG8_WAIT_L(0); PG8_MMA(0, 0, At, B0); PG8_BAR; PG8_SCHED;
      PG8_LDB(B1, 1, 1); PG8_STAGE(PG8_SB(1, 0), b3, voffB);
      PG8_BAR; PG8_WAIT_L(0); PG8_MMA(0, 1, At, B1); PG8_BAR;
      PG8_LDA(At, 1, 1); PG8_STAGE(PG8_SA(1, 0), a3, voffA);
      PG8_BAR; PG8_WAIT_L(0); PG8_MMA(1, 0, At, B0); PG8_BAR; PG8_SCHED;
      PG8_STAGE(PG8_SB(1, 1), b3 + hstepB, voffB);
      PG8_WAIT_V(6); PG8_BAR; PG8_MMA(1, 1, At, B1); PG8_BAR;
    }
    {
      const int t2 = otid(), wid2 = __builtin_amdgcn_readfirstlane(t2 >> 6), wr2 = wid2 >> 2, wc2 = wid2 & 3, fr2 = t2 & 15, fq2 = (t2 & 63) >> 4;
      const int row0 = cpm * BM + wr2 * 64 + fr2;
      const f32x4 z4 = {0.f, 0.f, 0.f, 0.f};
      constexpr int D1 = Epi::PERM ? 4 : 16, FQ = Epi::PERM ? 8 : 4;
      if constexpr (Epi::GU) {
        const int col0 = cpn * HALF + wc2 * 32 + FQ * fq2;
#pragma unroll
        for (int ai = 0; ai < 2; ++ai) {
          float rr[4]; f32x4 xa = z4, xb_ = z4;
#pragma unroll
          for (int m = 0; m < 4; ++m) { rr[m] = 0.f; E.pre(row0 + ai * HALF + m * 16, col0, rr[m], xa, xb_); }
#pragma unroll
          for (int m = 0; m < 4; ++m)
            E.op8(row0 + ai * HALF + m * 16, col0, acc[ai][0][m][0], acc[ai][1][m][0], acc[ai][0][m][1], acc[ai][1][m][1], rr[m]);
        }
      } else {
        const int col0 = cpn * BM + wc2 * 32 + FQ * fq2;
        f32x4 c0[2], c1[2];
#pragma unroll
        for (int bj = 0; bj < 2; ++bj) { c0[bj] = z4; c1[bj] = z4; E.template colpre<D1>(col0 + bj * HALF, c0[bj], c1[bj]); }
        constexpr int BR = Epi::BATCH_ROWS;
#pragma unroll
        for (int am = 0; am < 8 / BR; ++am) {
          const int r0b = am * BR;
          float rr[BR][2]; f32x4 x0[BR][2], x1[BR][2];
#pragma unroll
          for (int m = 0; m < BR; ++m)
#pragma unroll
            for (int bj = 0; bj < 2; ++bj) { const int rs = r0b + m; rr[m][bj] = 0.f; x0[m][bj] = z4; x1[m][bj] = z4;
              E.template pre<D1>(row0 + (rs >> 2) * HALF + (rs & 3) * 16, col0 + bj * HALF, rr[m][bj], x0[m][bj], x1[m][bj]); }
#pragma unroll
          for (int m = 0; m < BR; ++m)
#pragma unroll
            for (int bj = 0; bj < 2; ++bj) { const int rs = r0b + m;
              E.template op<D1>(row0 + (rs >> 2) * HALF + (rs & 3) * 16, col0 + bj * HALF, acc[rs >> 2][bj][rs & 3][0], acc[rs >> 2][bj][rs & 3][1], rr[m][bj], x0[m][bj], x1[m][bj], c0[bj], c1[bj]); }
        }
      }
    }
    if (!has_next) break;
#pragma unroll
    for (int a = 0; a < 2; ++a)
#pragma unroll
      for (int b = 0; b < 2; ++b)
#pragma unroll
        for (int m = 0; m < 4; ++m)
#pragma unroll
          for (int n = 0; n < 2; ++n) acc[a][b][m][n] = (f32x4){0.f, 0.f, 0.f, 0.f};
    cpm = npm; cpn = npn; cA = nA; cB = nB; ++ui;
  }
  PG8_WAIT_V(0);
  if (wr == 0) PG8_BAR;
  PG8_BAR;
#undef PG8_SA
#undef PG8_SB
#undef PG8_STAGE
#undef PG8_LDA
#undef PG8_LDB
#undef PG8_MMA
}

template <class Epi>
__device__ __forceinline__ void skinny(const Gemm g, int nitems, const Epi& E, int first_block = 0) {
  extern __shared__ __attribute__((aligned(16))) float sk_red[];
  const int tid = otid(), wave = __builtin_amdgcn_readfirstlane(tid >> 6), lane = tid & 63, G = gridDim.x;
  const int fr = lane & 15, fq = lane >> 4;
  const int nks = g.K >> 5;
  for (int it = (first_block ? (int)blockIdx.x - first_block + (blockIdx.x < (unsigned)first_block ? (1 << 28) : 0) : G - 1 - (int)blockIdx.x); it < nitems; it += (first_block ? G - first_block : G)) {
    int r0, r1, col, pn;
    if (Epi::GU) { pn = it >> 3; const int w = (it & 7) * 16; r0 = pn * 256 + w; r1 = r0 + 128; col = pn * 128 + w; }
    else { r0 = it * 32; r1 = r0 + 16; col = it * 32; pn = col >> 8; }
    const u16* ap = g.A + (size_t)pn * g.a_pn_el + (size_t)(MR + fr) * g.lda + fq * 8;
    const u16* b0p = g.Bt + (size_t)(r0 + fr) * g.ldb + fq * 8;
    const u16* b1p = g.Bt + (size_t)(r1 + fr) * g.ldb + fq * 8;
    f32x4 a0 = {0.f, 0.f, 0.f, 0.f}, a1 = {0.f, 0.f, 0.f, 0.f};
#pragma unroll 4
    for (int ks = wave; ks < nks; ks += 8) {
      const int k = ks * 32;
      const bf16x8 a = *(const bf16x8*)(ap + k);
      const bf16x8 b0 = *(const bf16x8*)(b0p + k);
      const bf16x8 b1 = *(const bf16x8*)(b1p + k);
      a0 = __builtin_amdgcn_mfma_f32_16x16x32_bf16(b0, a, a0, 0, 0, 0);
      a1 = __builtin_amdgcn_mfma_f32_16x16x32_bf16(b1, a, a1, 0, 0, 0);
    }
    __syncthreads();
    float* my = sk_red + (wave * 64 + lane) * 8;
    *(f32x4*)my = a0; *(f32x4*)(my + 4) = a1;
    __syncthreads();
    if (wave == 0) {
      f32x4 s0 = {0.f, 0.f, 0.f, 0.f}, s1 = {0.f, 0.f, 0.f, 0.f};
#pragma unroll
      for (int w = 0; w < 8; ++w) { s0 += *(const f32x4*)(sk_red + (w * 64 + lane) * 8); s1 += *(const f32x4*)(sk_red + (w * 64 + lane) * 8 + 4); }
      float r = 0.f; f32x4 x0 = {0.f, 0.f, 0.f, 0.f}, x1 = x0, c0 = x0, c1 = x0;
      if constexpr (Epi::GU) { E.pre(MR + fr, col + 4 * fq, r, x0, x1); E.op(MR + fr, col + 4 * fq, s0, s1, r); }
      else {
        E.template colpre<16>(col + 4 * fq, c0, c1);
        E.template pre<16>(MR + fr, col + 4 * fq, r, x0, x1);
        E.template op<16>(MR + fr, col + 4 * fq, s0, s1, r, x0, x1, c0, c1);
      }
    }
  }
  __syncthreads();
}
template <class Epi>
__device__ __forceinline__ void gemm_all(const Gemm g, int n_skinny, const Epi& E, int first_block = 0) {
  gemm_phase<Epi>(g, E);
  skinny<Epi>(g, n_skinny, E, first_block);
}

__device__ __forceinline__ void conv_tile(const float* __restrict__ src, int sld, int c0, int cvalid_end, int k0, int kend,
                          u16* __restrict__ dst, int dld, int r0, const float* __restrict__ gain) {
  extern __shared__ __attribute__((aligned(16))) float ctile[];
  const int tid = otid();
  __syncthreads();
  {
    const int j = tid & 63, i0 = tid >> 6;
    const bool cok = c0 + j < cvalid_end;
    float v[32];
#pragma unroll
    for (int e = 0; e < 32; ++e) {
      const int k = k0 + i0 + e * 8;
      v[e] = (cok && k < kend) ? src[(size_t)k * sld + c0 + j] : 0.f;
    }
    if (gain) {
#pragma unroll
      for (int e = 0; e < 32; ++e) { const int k = k0 + i0 + e * 8; v[e] *= (k < kend) ? gain[k] : 0.f; }
    }
#pragma unroll
    for (int e = 0; e < 32; ++e) ctile[(i0 + e * 8) * 65 + j] = v[e];
  }
  __syncthreads();
  {
    const int j = tid >> 3, ic = tid & 7;
#pragma unroll
    for (int q = 0; q < 4; ++q) {
      const int kk = (q * 8 + ic) * 8;
      if (k0 + kk < kend) {
        bf16x8 v;
#pragma unroll
        for (int e = 0; e < 8; ++e) v[e] = (short)f2bf(ctile[(kk + e) * 65 + j]);
        *(bf16x8*)(dst + (size_t)(r0 + j) * dld + k0 + kk) = v;
      }
    }
  }
}
__device__ __forceinline__ void conv_seg(const float* src, int sld, int c0, int ncols_valid, int ncols_pad, int K, u16* dst, int dld, int r0, const float* gain) {
  const int nct = ncols_pad / 64, nkt = (K + 255) / 256;
  for (int t = blockIdx.x; t < nct * nkt; t += gridDim.x) {
    const int ct = t % nct, kt = t / nct;
    conv_tile(src, sld, c0 + ct * 64, c0 + ncols_valid, kt * 256, K, dst, dld, r0 + ct * 64, gain);
  }
}

__device__ __forceinline__ void conv_ffn(PP p, int f, int t0, int stride, int tbeg = 0, int tend = 528) {
  unsigned char* ws = p->ws;
  const int l = f >> 1, s2 = f & 1;
  for (int t = tbeg + t0; t < tend; t += stride) {
    if (t < 352) {
      const int which = t & 1, n64 = (t >> 1) % 44, kt = (t >> 1) / 44;
      const float* src = p->in[(s2 ? 8 : 3) + which] + (size_t)l * 1024 * DFF;
      u16* dst = (u16*)(ws + WS_WGU + (size_t)f * WGU_ONE);
      conv_tile(src, DFF, n64 * 64, DFF, kt * 256, 1024, dst, 1024, (n64 >> 1) * 256 + which * 128 + (n64 & 1) * 64, p->in[s2 ? 7 : 2] + l * DM);
    } else {
      const int r = t - 352, ct = r % 16, kt = r / 16;
      const float* src = p->in[s2 ? 10 : 5] + (size_t)l * DFF * 1024;
      u16* dst = (u16*)(ws + WS_WD + (size_t)f * WD_ONE);
      conv_tile(src, 1024, ct * 64, 1024, kt * 256, DFF, dst, DFF, ct * 64, nullptr);
    }
  }
  __syncthreads();
}
__device__ __forceinline__ void conv_small(PP p) {
  unsigned char* ws = p->ws;
  for (int t = blockIdx.x; t < 256; t += gridDim.x) {
    const float* src; const float* gain = nullptr; u16* dst; int sld, c0, cend, k0, kend, dld, r0;
    if (t < 32) {
      const int i = t >> 2, ct = t & 3;
      src = p->in[11] + (size_t)i * 65536; sld = 256; c0 = ct * 64; cend = 256; k0 = 0; kend = 256;
      dst = (u16*)(ws + WS_WPOOL) + (size_t)i * 65536; dld = 256; r0 = ct * 64;
    } else if (t < 64) {
      const int r = t - 32, ct = r & 7, kt = r >> 3;
      src = p->in[14]; sld = 288; c0 = ct * 64; cend = 288; k0 = kt * 256; kend = 1024;
      dst = (u16*)(ws + WS_WDKV); dld = 1024; r0 = ct * 64; gain = p->in[13];
    } else if (t < 80) {
      const int r = t - 64, which = r >> 3, ct = r & 7;
      src = p->in[16 + which]; sld = 512; c0 = ct * 64; cend = 512; k0 = 0; kend = 256;
      dst = (u16*)(ws + WS_WUKV); dld = 256; r0 = which * 512 + ct * 64; gain = p->in[15];
    } else {
      const int r = (t - 80) % 88, j = (t - 80) / 88;
      if (r < 32) {
        const int ct = r & 7, kt = r >> 3;
        src = p->in[18] + (size_t)j * 1024 * 384; sld = 384; c0 = ct * 64; cend = 384; k0 = kt * 256; kend = 1024;
        dst = (u16*)(ws + WS_WDQ) + (size_t)j * 512 * 1024; dld = 1024; r0 = ct * 64; gain = p->in[6] + (2 + j) * DM;
      } else if (r < 56) {
        const int q = r - 32, ct = q % 12, kt = q / 12;
        src = p->in[20] + (size_t)j * 384 * 768; sld = 768; c0 = ct * 64; cend = 768; k0 = kt * 256; kend = 384;
        dst = (u16*)(ws + WS_WUQ) + (size_t)j * 768 * 384; dld = 384; r0 = ct * 64; gain = p->in[19] + j * 384;
      } else {
        const int q = r - 56, ct = q & 15, kt = q >> 4;
        src = p->in[21] + (size_t)j * 512 * 1024; sld = 1024; c0 = ct * 64; cend = 1024; k0 = kt * 256; kend = 512;
        dst = (u16*)(ws + WS_WO) + (size_t)j * 1024 * 512; dld = 512; r0 = ct * 64;
      }
    }
    conv_tile(src, sld, c0, cend, k0, kend, dst, dld, r0, gain);
  }
  __syncthreads();
}

template <int MODE>
__device__ __forceinline__ void norm_rows(PP p, const float* __restrict__ gain) {
  const int tid = otid(), wave = tid >> 6, lane = tid & 63;
  u16* HI = (u16*)(p->ws + WS_XN); u16* LO = (u16*)(p->ws + WS_LO);
  float* ss0 = (float*)(p->ws + WS_SS);
  const int nrows = (MODE == 2) ? MR : MALL;
  constexpr int NB = 8;
  const int stride = gridDim.x * 8;
  for (int row0 = blockIdx.x * 8 + wave; row0 < nrows; row0 += NB * stride) {
    f32x4 v[NB][4];
#pragma unroll
    for (int k = 0; k < NB; ++k) {
      const int row = row0 + k * stride;
      if (row < nrows) {
        if (MODE == 1) {
          const float* src = row < MR ? p->in[0] + (size_t)row * DM : p->in[1] + (size_t)(row - MR) * DM;
#pragma unroll
          for (int i = 0; i < 4; ++i) v[k][i] = ((const f32x4*)src)[i * 64 + lane];
        } else {
#pragma unroll
          for (int i = 0; i < 4; ++i) {
            const uint2 a = ((const uint2*)(HI + (size_t)row * DM))[i * 64 + lane], b = ((const uint2*)(LO + (size_t)row * DM))[i * 64 + lane];
            v[k][i] = hl_sum(a.x, a.y, b.x, b.y);
          }
        }
      } else {
#pragma unroll
        for (int i = 0; i < 4; ++i) v[k][i] = (f32x4){0.f, 0.f, 0.f, 0.f};
      }
    }
#pragma unroll
    for (int k = 0; k < NB; ++k) {
      const int row = row0 + k * stride;
      float ss = 0.f;
#pragma unroll
      for (int i = 0; i < 4; ++i) { const f32x4 q = v[k][i] * v[k][i]; ss += q[0] + q[1] + q[2] + q[3]; }
      ss = wave_sum(ss);
      if (row < nrows) {
        if (MODE == 1) {
          if (lane == 0) ss0[row] = ss;
#pragma unroll
          for (int i = 0; i < 4; ++i) {
            ushort4 hi, lo; hl_split(v[k][i], hi, lo);
            ((ushort4*)(HI + (size_t)row * DM))[i * 64 + lane] = hi;
            ((ushort4*)(LO + (size_t)row * DM))[i * 64 + lane] = lo;
          }
        } else {
          const float r = rsqrtf(ss * (1.f / DM) + EPS);
#pragma unroll
          for (int i = 0; i < 4; ++i) {
            const f32x4 g = ((const f32x4*)gain)[i * 64 + lane];
            ((f32x4*)(p->out + (size_t)row * DM))[i * 64 + lane] = v[k][i] * g * r;
          }
        }
      }
    }
  }
}

template <int W>
__device__ __forceinline__ void pool_seg(const u16* __restrict__ HB, const float* __restrict__ ss, const float* __restrict__ gain,
                                         u16* __restrict__ P, int b, int t0, int c8) {
  constexpr int NR = W - 1 + 8;
  bf16x8 v[NR]; float rr[NR];
#pragma unroll
  for (int j = 0; j < NR; ++j) {
    const int q = NMETA + t0 - (W - 1) + j;
    const int r = q >= NMETA ? b * SEQ + q - NMETA : MR + q;
    v[j] = *(const bf16x8*)(HB + (size_t)r * DM + c8 * 8);
    rr[j] = ss[r];
  }
  const f32x4 g0 = *(const f32x4*)(gain + c8 * 8), g1 = *(const f32x4*)(gain + c8 * 8 + 4);
  float S[8];
#pragma unroll
  for (int e = 0; e < 8; ++e) S[e] = 0.f;
#pragma unroll
  for (int j = 0; j < NR; ++j) {
    const float rj = rsqrtf(rr[j] * (1.f / DM) + EPS);
    float u[8];
#pragma unroll
    for (int e = 0; e < 8; ++e) { u[e] = bf2f((u16)v[j][e]) * rj; S[e] += u[e]; }
    if (j >= W - 1) {
      bf16x8 o;
#pragma unroll
      for (int e = 0; e < 8; ++e) o[e] = (short)f2bf((S[e] * (1.f / W) - u[e]) * (e < 4 ? g0[e & 3] : g1[e & 3]));
      *(bf16x8*)(P + (size_t)(b * SEQ + t0 + j - (W - 1)) * DM + c8 * 8) = o;
      const float ro = rsqrtf(rr[j - (W - 1)] * (1.f / DM) + EPS);
#pragma unroll
      for (int e = 0; e < 8; ++e) S[e] -= bf2f((u16)v[j - (W - 1)][e]) * ro;
    }
  }
}
__device__ __forceinline__ void pool_phase(const u16* __restrict__ HB, const float* __restrict__ ss, const float* __restrict__ gain, u16* __restrict__ P) {
  const int nitem = 4 * 2048 * 32;
  for (int i = blockIdx.x * NTHR + otid(); i < nitem; i += gridDim.x * NTHR) {
    const int c = i & 31, bseg = (i >> 5) & 2047, g = i >> 16;
    const int b = bseg >> 10, t0 = (bseg & 1023) * 8, c8 = g * 32 + c;
    if (g == 0) pool_seg<2>(HB, ss, gain, P, b, t0, c8);
    else if (g == 1) pool_seg<4>(HB, ss, gain, P, b, t0, c8);
    else if (g == 2) pool_seg<8>(HB, ss, gain, P, b, t0, c8);
    else pool_seg<16>(HB, ss, gain, P, b, t0, c8);
  }
  for (int idx = blockIdx.x * NTHR + otid(); idx < NMETA * 128; idx += gridDim.x * NTHR) {
    const int pos = idx >> 7, c8 = idx & 127, w = 2 << (c8 >> 5);
    const int cnt = min(w, pos + 1);
    float acc[8], self[8];
#pragma unroll
    for (int e = 0; e < 8; ++e) { acc[e] = 0.f; self[e] = 0.f; }
    bf16x8 v[16]; float rr[16];
#pragma unroll
    for (int j = 0; j < 16; ++j) {
      v[j] = (bf16x8){0, 0, 0, 0, 0, 0, 0, 0}; rr[j] = 1.f;
      if (j < cnt) { const int r = MR + pos - j; v[j] = *(const bf16x8*)(HB + (size_t)r * DM + c8 * 8); rr[j] = ss[r]; }
    }
#pragma unroll
    for (int j = 0; j < 16; ++j) {
      const float rj = (j < cnt) ? rsqrtf(rr[j] * (1.f / DM) + EPS) : 0.f;
#pragma unroll
      for (int e = 0; e < 8; ++e) { const float f = bf2f((u16)v[j][e]) * rj; acc[e] += f; if (j == 0) self[e] = f; }
    }
    const float inv = 1.f / (float)cnt;
    const f32x4 g0 = *(const f32x4*)(gain + c8 * 8), g1 = *(const f32x4*)(gain + c8 * 8 + 4);
    bf16x8 o;
#pragma unroll
    for (int e = 0; e < 8; ++e) o[e] = (short)f2bf((acc[e] * inv - self[e]) * (e < 4 ? g0[e & 3] : g1[e & 3]));
    *(bf16x8*)(P + (size_t)(MR + pos) * DM + c8 * 8) = o;
  }
}

constexpr int KPITCH = 208, VPITCH = 144, KBYTES = 64 * KPITCH, ABUF = KBYTES + 64 * VPITCH;
__device__ __forceinline__ void attn_block(PP p, int b, int h, int qb) {
  extern __shared__ __attribute__((aligned(16))) unsigned char alds[];
  const int tid = otid(), wave = tid >> 6, lane = tid & 63, l32 = lane & 31, hl = lane >> 5;
  const u16* Q = (const u16*)(p->ws + WS_G + GA_Q);
  u16* O = (u16*)(p->ws + WS_G + GA_O);
  const bool meta = qb < 0;
  int qrow, cw, cmax;
  if (!meta) { qrow = b * SEQ + qb * 256 + wave * 32 + l32; cw = qb * 4 + (wave >> 1); cmax = qb * 4 + 3; }
  else { qrow = MR + min(l32, 15); cw = (wave == 0) ? -1 : -2; cmax = -1; }
  bf16x8 qf[6];
  {
    const u16* qp = Q + (size_t)qrow * 768 + h * 96 + hl * 8;
#pragma unroll
    for (int ks = 0; ks < 6; ++ks) qf[ks] = *(const bf16x8*)(qp + ks * 16);
  }
  f32x16 o0, o1;
#pragma unroll
  for (int i = 0; i < 16; ++i) { o0[i] = 0.f; o1[i] = 0.f; }
  float mrun = -1e30f, lsum = 0.f;
  const u16* Kg = (const u16*)p->out + (size_t)((b * 8 + h) * SEQ) * 96;
  const u16* Vg = (const u16*)p->out + KF_ELEMS + (size_t)((b * 8 + h) * 64) * SEQ;
  const u16* Kmg = (const u16*)(p->ws + WS_KM) + h * 64 * 96;
  const u16* Vmg = (const u16*)(p->ws + WS_VM) + h * 64 * 64;
  const int vdv = tid >> 3, vpart = tid & 7;
  const int kw0 = (tid / 12) * KPITCH + (tid % 12) * 16;
  const int kw1 = ((tid + 512) / 12) * KPITCH + ((tid + 512) % 12) * 16;
  const int vw = KBYTES + vdv * VPITCH + vpart * 16;
  uint4 kr0, kr1 = make_uint4(0, 0, 0, 0), vr;
#define ATT_LOAD(kt) do { const uint4* ks_ = (const uint4*)((kt) < 0 ? Kmg : Kg + (size_t)(kt) * 64 * 96); \
    kr0 = ks_[tid]; if (tid < 256) kr1 = ks_[tid + 512]; \
    vr = *(const uint4*)((kt) < 0 ? Vmg + vdv * 64 + vpart * 8 : Vg + (size_t)vdv * SEQ + (kt) * 64 + vpart * 8); } while (0)
#define ATT_WRITE(buf) do { unsigned char* b_ = alds + (buf) * ABUF; *(uint4*)(b_ + kw0) = kr0; if (tid < 256) *(uint4*)(b_ + kw1) = kr1; \
    *(uint4*)(b_ + vw) = vr; } while (0)
  ATT_LOAD(-1);
  ATT_WRITE(0);
  __syncthreads();
  int it = 0;
  for (int kt = -1; kt <= cmax; ++kt, ++it) {
    const int buf = it & 1;
    if (kt < cmax) ATT_LOAD(kt + 1);
    if (kt <= cw) {
      const unsigned char* kb = alds + buf * ABUF;
      const unsigned char* vb = kb + KBYTES;
      f32x16 s0, s1;
#pragma unroll
      for (int i = 0; i < 16; ++i) { s0[i] = 0.f; s1[i] = 0.f; }
#pragma unroll
      for (int ks = 0; ks < 6; ++ks) {
        const bf16x8 k0 = *(const bf16x8*)(kb + l32 * KPITCH + ks * 32 + hl * 16);
        const bf16x8 k1 = *(const bf16x8*)(kb + (32 + l32) * KPITCH + ks * 32 + hl * 16);
        s0 = __builtin_amdgcn_mfma_f32_32x32x16_bf16(k0, qf[ks], s0, 0, 0, 0);
        s1 = __builtin_amdgcn_mfma_f32_32x32x16_bf16(k1, qf[ks], s1, 0, 0, 0);
      }
      if (kt < 0) {
#pragma unroll
        for (int i = 8; i < 16; ++i) s0[i] = -1e30f;
#pragma unroll
        for (int i = 0; i < 16; ++i) s1[i] = -1e30f;
      }
      float mx = s0[0];
#pragma unroll
      for (int i = 1; i < 16; ++i) mx = fmaxf(mx, s0[i]);
#pragma unroll
      for (int i = 0; i < 16; ++i) mx = fmaxf(mx, s1[i]);
      mx = xhalf_max(mx);
      const float mnew = fmaxf(mrun, mx);
      const float alpha = __builtin_amdgcn_exp2f(mrun - mnew);
      mrun = mnew;
      float ps = 0.f;
#pragma unroll
      for (int i = 0; i < 16; ++i) { s0[i] = __builtin_amdgcn_exp2f(s0[i] - mnew); ps += s0[i]; }
#pragma unroll
      for (int i = 0; i < 16; ++i) { s1[i] = __builtin_amdgcn_exp2f(s1[i] - mnew); ps += s1[i]; }
      lsum = lsum * alpha + ps;
#pragma unroll
      for (int i = 0; i < 16; ++i) { o0[i] *= alpha; o1[i] *= alpha; }
#pragma unroll
      for (int jp = 0; jp < 4; ++jp) {
        bf16x8 pf;
#pragma unroll
        for (int e = 0; e < 8; ++e) pf[e] = (short)f2bf((jp < 2) ? s0[(jp & 1) * 8 + e] : s1[(jp & 1) * 8 + e]);
        const bf16x8 v0 = *(const bf16x8*)(vb + l32 * VPITCH + (jp * 16 + hl * 8) * 2);
        const bf16x8 v1 = *(const bf16x8*)(vb + (32 + l32) * VPITCH + (jp * 16 + hl * 8) * 2);
        o0 = __builtin_amdgcn_mfma_f32_32x32x16_bf16(v0, pf, o0, 0, 0, 0);
        o1 = __builtin_amdgcn_mfma_f32_32x32x16_bf16(v1, pf, o1, 0, 0, 0);
        }
    }
    if (kt < cmax) ATT_WRITE(buf ^ 1);
    __syncthreads();
  }
#undef ATT_LOAD
#undef ATT_WRITE
  const float ltot = xhalf_sum(lsum);
  if (cw >= -1 && (!meta || l32 < 16)) {
    const float inv = 1.f / ltot;
    u16* op = O + (size_t)qrow * 512 + h * 64 + 4 * hl;
#pragma unroll
    for (int g4 = 0; g4 < 4; ++g4) {
      ushort4 a, c;
      a.x = f2bf(o0[g4 * 4 + 0] * inv); a.y = f2bf(o0[g4 * 4 + 1] * inv); a.z = f2bf(o0[g4 * 4 + 2] * inv); a.w = f2bf(o0[g4 * 4 + 3] * inv);
      c.x = f2bf(o1[g4 * 4 + 0] * inv); c.y = f2bf(o1[g4 * 4 + 1] * inv); c.z = f2bf(o1[g4 * 4 + 2] * inv); c.w = f2bf(o1[g4 * 4 + 3] * inv);
      *(ushort4*)(op + 8 * g4) = a;
      *(ushort4*)(op + 32 + 8 * g4) = c;
    }
  }
}

__device__ __forceinline__ void attn_phase(PP p) {
  const int G = gridDim.x;
  for (int it = blockIdx.x; it < 256; it += G) {
    const int nsub = it < 256 ? 2 : 1;
    for (int sub = 0; sub < nsub; ++sub) {
      int b, h, qb;
      if (it < 256) { const int bh = it >> 4, i = it & 15; b = bh >> 3; h = bh & 7; qb = sub ? i : 31 - i; }
      else { b = 0; h = it - 256; qb = -1; }
      attn_block(p, b, h, qb);
    }
  }
}

__device__ __forceinline__ void misc_init(PP p) {
  float2* rope = (float2*)(p->ws + WS_ROPE);
  for (int idx = blockIdx.x * NTHR + otid(); idx < 8208 * 16; idx += gridDim.x * NTHR) {
    const int pos = idx >> 4, i = idx & 15;
    const float inv = 1.0f / powf(10000.f, (float)(2 * i) / 32.f);
    const float ang = (float)pos * inv;
    float s, c; sincosf(ang, &s, &c);
    rope[idx] = make_float2(c, s);
  }
  unsigned* z = (unsigned*)(p->ws + WS_KM);
  const int nz = (int)((WS_HM - WS_KM) / 4);
  for (int idx = blockIdx.x * NTHR + otid(); idx < nz; idx += gridDim.x * NTHR) z[idx] = 0u;
  unsigned* zs = (unsigned*)(p->ws + WS_SS) + SSLD;
  for (int idx = blockIdx.x * NTHR + otid(); idx < (NSLOT - 1) * SSLD; idx += gridDim.x * NTHR) zs[idx] = 0u;
}

#define XB_TMO      128
#define XB_XCNT(j)  (256  + 64 * (j))
#define XB_XSUB(j)  (1280 + 64 * (j))
#define XB_XGEN(j)  (2304 + 64 * (j))
#define XB_TOP      3328
#define XB_TOPGEN   3392
#define XCD_BAR_WORDS 3456
#define XB_SPIN_CAP (1u << 20)
DI unsigned xb_ld(unsigned* p)              { return __hip_atomic_load(p, __ATOMIC_RELAXED, __HIP_MEMORY_SCOPE_AGENT); }
DI unsigned xb_add(unsigned* p, unsigned v) { return __hip_atomic_fetch_add(p, v, __ATOMIC_RELAXED, __HIP_MEMORY_SCOPE_AGENT); }
DI unsigned xb_xcc_id() { return (unsigned)__builtin_amdgcn_s_getreg((3 << 11) | 20) & 0xFu; }
#define XB_SPIN(cond, bar) do { unsigned _sp = 0; while (cond) { __builtin_amdgcn_s_sleep(1); \
    if ((++_sp & 255u) == 0u) { if (xb_ld(&(bar)[XB_TMO])) break; if (_sp > XB_SPIN_CAP) { atomicAdd(&(bar)[XB_TMO], 1u); break; } } } } while (0)
struct XcdBarrier { unsigned* bar; unsigned x; volatile LAS unsigned* st; };
DI XcdBarrier xcd_barrier_post(unsigned* bar, volatile LAS unsigned* st) {
  XcdBarrier b; b.bar = bar; b.x = xb_xcc_id(); b.st = st;
  if (threadIdx.x == 0) (void)xb_add(&bar[XB_XCNT(b.x)], 1u);
  return b;
}
DI void xcd_barrier_complete(unsigned* bar, unsigned x, unsigned& nloc, unsigned& nx) {
  const unsigned G = gridDim.x * gridDim.y * gridDim.z;
  unsigned sum, cnt, mine, sp = 0u;
  for (;;) {
    sum = 0u; cnt = 0u; mine = 0u;
#pragma unroll
    for (unsigned j = 0; j < 16; ++j) { const unsigned c = xb_ld(&bar[XB_XCNT(j)]); sum += c; cnt += (c > 0u) ? 1u : 0u; mine = (j == x) ? c : mine; }
    if (sum == G) break;
    __builtin_amdgcn_s_sleep(1);
    if ((++sp & 255u) == 0u) { if (xb_ld(&bar[XB_TMO])) break; if (sp > XB_SPIN_CAP) { atomicAdd(&bar[XB_TMO], 1u); break; } }
  }
  nloc = mine > 0u ? mine : 1u; nx = cnt > 0u ? cnt : 1u;
}
DI void xcd_barrier(const XcdBarrier& b) {
  asm volatile("s_waitcnt vmcnt(0)" ::: "memory");
  __syncthreads();
  if (threadIdx.x == 0) {
    unsigned* bar = b.bar;
    unsigned bx = __builtin_amdgcn_readfirstlane(b.x); asm volatile("" : "+s"(bx));
    __builtin_amdgcn_s_waitcnt(0);
    unsigned nloc = b.st[0], nx = b.st[1];
    if (nloc == 0u) { xcd_barrier_complete(bar, bx, nloc, nx); b.st[0] = nloc; b.st[1] = nx; }
    const unsigned old = xb_add(&bar[XB_XSUB(bx)], 1u);
    const unsigned gen = old / nloc;
    if (old + 1u == (gen + 1u) * nloc) {
      __builtin_amdgcn_fence(__ATOMIC_RELEASE, "agent");
      asm volatile("s_waitcnt vmcnt(0)" ::: "memory");
      const unsigned og = xb_add(&bar[XB_TOP], 1u);
      const unsigned tg = og / nx;
      if (og + 1u == (tg + 1u) * nx) xb_add(&bar[XB_TOPGEN], 1u);
      else XB_SPIN(xb_ld(&bar[XB_TOPGEN]) == tg, bar);
      __builtin_amdgcn_fence(__ATOMIC_ACQUIRE, "agent");
      xb_add(&bar[XB_XGEN(bx)], 1u);
      asm volatile("s_waitcnt vmcnt(0)" ::: "memory");
    } else {
      XB_SPIN(xb_ld(&bar[XB_XGEN(bx)]) == gen, bar);
      __builtin_amdgcn_fence(__ATOMIC_ACQUIRE, "agent");
      asm volatile("s_waitcnt vmcnt(0)" ::: "memory");
    }
  }
  __syncthreads();
}

#define GSYNC() do { xcd_barrier(xb); p = launder(p); } while (0)
__device__ __forceinline__ void ffn(PP p, int f, int sin, int sout, const XcdBarrier& xb, bool with_kv, bool meta) {
  if (with_kv) {
    unsigned char* ws = p->ws; float* SS = (float*)(ws + WS_SS);
    EpiDKV E{(u16*)(ws + WS_CKV), SS + (size_t)sin * SSLD, SS + (size_t)SLOT_KV * SSLD, (const float*)(ws + WS_ROPE), (u16*)p->out, (u16*)(ws + WS_KM)};
    gemm_all<EpiDKV>(Gemm{(const u16*)(ws + WS_XN), (const u16*)(ws + WS_WDKV), 1024, 1024, 1024, 2, 0, 128}, 9, E);
  }
  {
    unsigned char* ws = p->ws;
    EpiSwiglu E{(u16*)(ws + WS_G), (const float*)(ws + WS_SS) + (size_t)sin * SSLD};
    gemm_all<EpiSwiglu>(Gemm{(const u16*)(ws + WS_XN), (const u16*)(ws + WS_WGU + (size_t)f * WGU_ONE), 1024, 1024, 1024, 22, 0, 0}, meta ? DFF / 16 : 0, E, ogdim() == 256 ? 128 : 0);
    if (f < 7) { const int gd = ogdim(), bid = obid();
      if (gd == 256) { if (bid >= 128) { if (f == 0) conv_ffn(p, 0, bid - 128, 128, 352, 528); conv_ffn(p, f + 1, bid - 128, 128); } }
      else { if (f == 0) conv_ffn(p, 0, bid, gd, 352, 528); conv_ffn(p, f + 1, bid, gd); } }
    if (DUP_GU) { xcd_barrier(xb); gemm_phase<EpiSwiglu>(Gemm{(const u16*)(ws + WS_XN), (const u16*)(ws + WS_WGU + (size_t)f * WGU_ONE), 1024, 1024, 1024, 22, 0, 0}, E); }
    if (DUP_SKINNY) { xcd_barrier(xb); skinny<EpiSwiglu>(Gemm{(const u16*)(ws + WS_XN), (const u16*)(ws + WS_WGU + (size_t)f * WGU_ONE), 1024, 1024, 1024, 22, 0, 0}, DFF / 16, E); }
  }
  GSYNC();
  {
    unsigned char* ws = p->ws;
    EpiResidT<false> E{(u16*)(ws + WS_XN), (u16*)(ws + WS_LO), (float*)(ws + WS_SS) + (size_t)sout * SSLD, nullptr, 0.5f};
    gemm_all<EpiResidT<false>>(Gemm{(const u16*)(ws + WS_G), (const u16*)(ws + WS_WD + (size_t)f * WD_ONE), DFF, DFF, DFF, 4, 0, 0}, meta ? 1024 / 32 : 0, E);
  }
  if (with_kv) {
    unsigned char* ws = p->ws; float* SS = (float*)(ws + WS_SS);
    EpiKV E{(u16*)p->out, (u16*)p->out + KF_ELEMS, (u16*)(ws + WS_KM), (u16*)(ws + WS_VM), SS + (size_t)SLOT_KV * SSLD};
    gemm_all<EpiKV>(Gemm{(const u16*)(ws + WS_CKV), (const u16*)(ws + WS_WUKV), 256, 256, 256, 4, 0, 0}, 32, E);
  }
  GSYNC();
}

__global__ void __launch_bounds__(NTHR, 2) mega(Params p_unused) {
  extern __shared__ __attribute__((aligned(16))) unsigned char shm_top[];
  cg::grid_group grid = cg::this_grid();
  PP p = launder((PP)__builtin_amdgcn_kernarg_segment_ptr());

  if (threadIdx.x < 4) ((volatile LAS unsigned*)((LAS unsigned char*)shm_top + SHM_B))[threadIdx.x] = 0u;
  if (gridDim.x == 0x7fffffffu) grid.sync();
  norm_rows<1>(p, nullptr);
  misc_init(p);
  conv_ffn(p, 0, blockIdx.x, gridDim.x, 0, 352);
  conv_small(p);
  p = launder(p);
  const XcdBarrier xb = xcd_barrier_post((unsigned*)(p->ws + WS_BAR), (volatile LAS unsigned*)((LAS unsigned char*)shm_top + SHM_B));
  GSYNC();

  for (int l = 0; l < DEPTH; ++l) {
    ffn(p, l * 2, 3 * l, 3 * l + 1, xb, l == 2, l < 2);
    unsigned char* ws = p->ws;
    float* SS = (float*)(ws + WS_SS);
    u16* HB = (u16*)(ws + WS_XN);
    float* Hm = (float*)(ws + WS_HM);
    if (l < 2) {
      u16* P = (u16*)(ws + WS_G + GA_P);
      pool_phase(HB, SS + (size_t)(3 * l + 1) * SSLD, p->in[6] + l * DM, P);
      GSYNC();
      ws = p->ws; SS = (float*)(ws + WS_SS); HB = (u16*)(ws + WS_XN); Hm = (float*)(ws + WS_HM); P = (u16*)(ws + WS_G + GA_P);
      {
        EpiResidT<true> E{HB, (u16*)(ws + WS_LO), SS + (size_t)(3 * l + 2) * SSLD, p->in[12] + l * DM, 1.f};
        gemm_all<EpiResidT<true>>(Gemm{P, (const u16*)(ws + WS_WPOOL) + (size_t)l * 4 * 65536, 1024, 256, 256, 4, 256, 0}, 32, E);
      }
      GSYNC();
    } else {
      const int j = l - 2;
      {
        EpiDQ E{(u16*)(ws + WS_G + GA_CQN), SS + (size_t)(3 * l + 1) * SSLD, SS + (size_t)(SLOT_Q + j) * SSLD};
        gemm_all<EpiDQ>(Gemm{HB, (const u16*)(ws + WS_WDQ) + (size_t)j * 512 * 1024, 1024, 1024, 1024, 2, 0, 0}, 0, E);
      }
      GSYNC();
      ws = p->ws; SS = (float*)(ws + WS_SS);
      {
        EpiQ E{(u16*)(ws + WS_G + GA_Q), (const float*)(ws + WS_ROPE), SS + (size_t)(SLOT_Q + j) * SSLD, 0.10206207261596577f * 1.4426950408889634f};
        gemm_all<EpiQ>(Gemm{(const u16*)(ws + WS_G + GA_CQN), (const u16*)(ws + WS_WUQ) + (size_t)j * 768 * 384, 384, 384, 384, 3, 0, 0}, 0, E);
      }
      GSYNC();
      attn_phase(p);
      if (DUP_ATTN) { GSYNC(); attn_phase(p); }
      GSYNC();
      ws = p->ws; SS = (float*)(ws + WS_SS); HB = (u16*)(ws + WS_XN); Hm = (float*)(ws + WS_HM);
      {
        EpiResidT<false> E{HB, (u16*)(ws + WS_LO), SS + (size_t)(3 * l + 2) * SSLD, nullptr, 1.f};
        gemm_all<EpiResidT<false>>(Gemm{(const u16*)(ws + WS_G + GA_O), (const u16*)(ws + WS_WO) + (size_t)j * 1024 * 512, 512, 512, 512, 4, 0, 0}, 0, E);
      }
      GSYNC();
    }
    ffn(p, l * 2 + 1, 3 * l + 2, 3 * l + 3, xb, false, l < 2);
  }
  norm_rows<2>(p, p->in[22]);
}

extern "C" void kernel_launch(void* const* d_in, const int* in_sizes, int n_in, void* d_out, int out_size,
                              void* d_ws, size_t ws_size, hipStream_t stream) {
  static int grid_blocks = 0;
  if (grid_blocks == 0) {
    if (n_in != 23 || out_size != MR * DM || ws_size < WS_END) {
      fprintf(stderr, "kernel_launch: unexpected problem (n_in %d out %d ws %zu need %zu)\n", n_in, out_size, ws_size, (size_t)WS_END);
      grid_blocks = -1; return;
    }
    int dev = 0, cus = 0, per_cu = 0;
    hipGetDevice(&dev);
    hipDeviceGetAttribute(&cus, hipDeviceAttributeMultiprocessorCount, dev);
    hipFuncSetAttribute((const void*)mega, hipFuncAttributeMaxDynamicSharedMemorySize, SHM_B + 16);
    hipOccupancyMaxActiveBlocksPerMultiprocessor(&per_cu, (const void*)mega, NTHR, SHM_B + 16);
    if (per_cu < 1) { fprintf(stderr, "kernel_launch: occupancy query says %d blocks/CU\n", per_cu); per_cu = 1; }
    grid_blocks = cus * 1;
    (void)hipGetLastError();
  }
  if (grid_blocks < 0) return;
  (void)hipMemsetAsync((unsigned char*)d_ws + WS_BAR, 0, 16384, stream);
  Params hp{};
  for (int i = 0; i < 23; ++i) hp.in[i] = (const float*)d_in[i];
  hp.out = (float*)d_out; hp.ws = (unsigned char*)d_ws;
  void* args[] = {&hp};
  hipError_t e = hipLaunchCooperativeKernel((const void*)mega, dim3(grid_blocks), dim3(NTHR), args, SHM_B + 16, stream);
  if (e != hipSuccess) fprintf(stderr, "cooperative launch failed: %s (grid %d)\n", hipGetErrorString(e), grid_blocks);
}
```
